# Optimizing an MI355X kernel written in HIP

```python
import jax
import jax.numpy as jnp
from jax import lax
import numpy as np

D_MODEL = 2048
BATCH = 8
SEQ = 2048
DEPTH = 2

CTX_LEN = 256
GRID_W = 64
N_MIXERS = 2
EPS = 1e-6
N_MOD = 6
RG_WIDTH = D_MODEL
RG_HEADS = 16
RG_HEAD_DIM = RG_WIDTH // RG_HEADS
RG_CONV = 4
RG_CONV_LEFT = 2
RG_C = 8.0
RG_A_MIN = 0.9
RG_A_MAX = 0.999
HG_HEADS = 16
HG_DK = D_MODEL // HG_HEADS
HG_DV = D_MODEL // HG_HEADS
HG_CHUNK = 32
D_FF = ((8 * D_MODEL + 3 * 256 - 1) // (3 * 256)) * 256
N_RG = (DEPTH + N_MIXERS - 1) // N_MIXERS
N_HG = DEPTH // N_MIXERS

kernel_name = 'hybrid_rglru_hgrn2_flow_block'


def _rms(x, g):
    xf = x.astype(jnp.float32)
    y = xf * lax.rsqrt(jnp.mean(xf * xf, axis=-1, keepdims=True) + EPS)
    return y.astype(x.dtype) * g


def _ada(cvec, w, b):
    m = jax.nn.silu(cvec) @ w + b
    return [t[:, None, :] for t in jnp.split(m, N_MOD, axis=-1)]


def _modulate(x, g, shift, scale):
    return _rms(x, g) * (1.0 + scale) + shift


def _swiglu(h, w_in, w_out):
    gate, up = jnp.split(h @ w_in, 2, axis=-1)
    return (jax.nn.silu(gate) * up) @ w_out


def _to_col_major(h, rows):
    bn, l, d = h.shape
    return h.reshape(bn, rows, GRID_W, d).transpose(0, 2, 1, 3).reshape(bn, l, d)


def _from_col_major(h, rows):
    bn, l, d = h.shape
    return h.reshape(bn, GRID_W, rows, d).transpose(0, 2, 1, 3).reshape(bn, l, d)


def _centred_conv(x, w, b):
    l = x.shape[1]
    xp = jnp.pad(x, ((0, 0), (RG_CONV_LEFT, RG_CONV - 1 - RG_CONV_LEFT), (0, 0)))
    y = b
    for k in range(RG_CONV):
        y = y + w[k] * xp[:, k:k + l]
    return y


def _rglru_coeffs(xc, w_a, b_a, w_i, b_i, lam):
    bn, l, wd = xc.shape
    xh = xc.reshape(bn, l, RG_HEADS, RG_HEAD_DIM)
    r = jax.nn.sigmoid(jnp.einsum('blhd,hde->blhe', xh, w_a) + b_a).reshape(bn, l, wd).astype(jnp.float32)
    ig = jax.nn.sigmoid(jnp.einsum('blhd,hde->blhe', xh, w_i) + b_i).reshape(bn, l, wd).astype(jnp.float32)
    log_a = -RG_C * r * jax.nn.softplus(-lam.astype(jnp.float32))
    a = jnp.exp(log_a)
    b = jnp.sqrt(-jnp.expm1(2.0 * log_a)) * ig * xc.astype(jnp.float32)
    return a, b


def _linear_scan(a, b, h0):
    def comb(lft, rgt):
        return (lft[0] * rgt[0], rgt[0] * lft[1] + rgt[1])
    a_cum, b_cum = lax.associative_scan(comb, (a, b), axis=1)
    h = a_cum * h0[:, None, :] + b_cum
    return h, h[:, -1]


def _rglru_dir(xc_ctx, xc_lat, w_a, b_a, w_i, b_i, lam, reverse):
    flip = (lambda t: jnp.flip(t, axis=1)) if reverse else (lambda t: t)
    h0 = jnp.zeros((xc_ctx.shape[0], RG_WIDTH), jnp.float32)
    a_c, b_c = _rglru_coeffs(flip(xc_ctx), w_a, b_a, w_i, b_i, lam)
    h_c, s_c = _linear_scan(a_c, b_c, h0)
    a_l, b_l = _rglru_coeffs(flip(xc_lat), w_a, b_a, w_i, b_i, lam)
    h_l, _ = _linear_scan(a_l, b_l, s_c)
    return flip(h_c), flip(h_l)


def _rglru_mixer(h_ctx, h_lat, w_in, conv_w, conv_b, w_a, b_a, w_i, b_i, lam, w_out, need_ctx):
    xb_c, gb_c = jnp.split(h_ctx @ w_in, 2, axis=-1)
    xb_l, gb_l = jnp.split(h_lat @ w_in, 2, axis=-1)
    xc_c = _centred_conv(xb_c, conv_w, conv_b)
    xc_l = _centred_conv(xb_l, conv_w, conv_b)
    hcf, hlf = _rglru_dir(xc_c, xc_l, w_a[0], b_a[0], w_i[0], b_i[0], lam[0], False)
    hcb, hlb = _rglru_dir(xc_c, xc_l, w_a[1], b_a[1], w_i[1], b_i[1], lam[1], True)
    y_l = ((hlf + hlb).astype(h_lat.dtype) * jax.nn.gelu(gb_l)) @ w_out
    y_c = ((hcf + hcb).astype(h_ctx.dtype) * jax.nn.gelu(gb_c)) @ w_out if need_ctx else None
    return y_c, y_l


def _hgrn2_chunk_scan(q, k, v, log_f, s0):
    bn, l, h, _ = q.shape
    n = l // HG_CHUNK

    def chunks(t):
        return t.reshape(bn, n, HG_CHUNK, h, t.shape[-1]).transpose(1, 0, 3, 2, 4)

    mask = jnp.tril(jnp.ones((HG_CHUNK, HG_CHUNK), dtype=bool))

    def step(s, inp):
        qc, kc, vc, gc = inp
        b = jnp.cumsum(gc, axis=2)
        o_inter = jnp.einsum('bhjd,bhde->bhje', qc * jnp.exp(b), s)
        diff = jnp.where(mask[:, :, None], b[:, :, :, None, :] - b[:, :, None, :, :], -jnp.inf)
        att = jnp.einsum('bhjsd,bhsd->bhjs', qc[:, :, :, None, :] * jnp.exp(diff), kc)
        o_intra = jnp.einsum('bhjs,bhse->bhje', att, vc)
        b_last = b[:, :, -1:, :]
        s_new = jnp.exp(b_last[:, :, 0, :, None]) * s + jnp.einsum('bhsd,bhse->bhde', kc * jnp.exp(b_last - b), vc)
        return s_new, o_inter + o_intra

    s_fin, o = lax.scan(step, s0, (chunks(q), chunks(k), chunks(v), chunks(log_f)))
    o = o.transpose(1, 0, 3, 2, 4).reshape(bn, l, h, v.shape[-1])
    return o, s_fin


def _hgrn2_feats(h, w_in, lb):
    bn, l, _ = h.shape
    q, f_fwd, f_bwd, v, g = jnp.split(h @ w_in, 5, axis=-1)
    heads = lambda t: t.reshape(bn, l, HG_HEADS, -1).astype(jnp.float32)
    q = heads(q) * (HG_DK ** -0.5)
    gates = []
    for d, fz in enumerate((f_fwd, f_bwd)):
        z = heads(fz)
        lbd = lb[d]
        log_f = jnp.logaddexp(jnp.log(lbd), jnp.log1p(-lbd) + jax.nn.log_sigmoid(z))
        k = (1.0 - lbd) * jax.nn.sigmoid(-z)
        gates.append((k, log_f))
    return q, heads(v), heads(g), gates


def _hgrn2_dir(q_c, k_c, v_c, lf_c, q_l, k_l, v_l, lf_l, reverse):
    flip = (lambda t: jnp.flip(t, axis=1)) if reverse else (lambda t: t)
    s0 = jnp.zeros((q_c.shape[0], HG_HEADS, HG_DK, HG_DV), jnp.float32)
    o_c, s_c = _hgrn2_chunk_scan(flip(q_c), flip(k_c), flip(v_c), flip(lf_c), s0)
    o_l, _ = _hgrn2_chunk_scan(flip(q_l), flip(k_l), flip(v_l), flip(lf_l), s_c)
    return flip(o_c), flip(o_l)


def _hgrn2_out(o, g, norm_w, w_out, dtype):
    bn, l = o.shape[:2]
    o = o * lax.rsqrt(jnp.mean(o * o, axis=-1, keepdims=True) + EPS) * norm_w * jax.nn.silu(g)
    return o.reshape(bn, l, HG_HEADS * HG_DV).astype(dtype) @ w_out


def _hgrn2_mixer(h_ctx, h_lat, w_in, lb, norm_w, w_out, need_ctx):
    qc, vc, gc, gates_c = _hgrn2_feats(h_ctx, w_in, lb)
    ql, vl, gl, gates_l = _hgrn2_feats(h_lat, w_in, lb)
    ocf, olf = _hgrn2_dir(qc, gates_c[0][0], vc, gates_c[0][1], ql, gates_l[0][0], vl, gates_l[0][1], False)
    ocb, olb = _hgrn2_dir(qc, gates_c[1][0], vc, gates_c[1][1], ql, gates_l[1][0], vl, gates_l[1][1], True)
    y_l = _hgrn2_out(olf + olb, gl, norm_w, w_out, h_lat.dtype)
    y_c = _hgrn2_out(ocf + ocb, gc, norm_w, w_out, h_ctx.dtype) if need_ctx else None
    return y_c, y_l


def setup_inputs(seed: int = 0) -> dict:
    key = jax.random.key(seed)
    ks = jax.random.split(key, 32)
    f32 = jnp.float32
    nrm = lambda k, shape, s: jax.random.normal(k, shape, f32) * s
    D, W, F = D_MODEL, RG_WIDTH, D_FF
    u = jax.random.uniform(ks[14], (N_RG, 2, W), f32, RG_A_MIN, RG_A_MAX)
    s = u ** (1.0 / RG_C)
    return {
        'x': nrm(ks[0], (BATCH, SEQ, D), 1.0),
        'c': nrm(ks[1], (BATCH, D), 1.0),
        'ctx': nrm(ks[2], (BATCH, CTX_LEN, D), 1.0),
        'c_ctx': nrm(ks[3], (D,), 1.0),
        'w_ada': nrm(ks[4], (DEPTH, D, N_MOD * D), 0.5 * D ** -0.5),
        'b_ada': nrm(ks[5], (DEPTH, N_MOD * D), 0.01),
        'g_mix': 1.0 + nrm(ks[6], (DEPTH, D), 0.02),
        'g_ffn': 1.0 + nrm(ks[7], (DEPTH, D), 0.02),
        'g_final': 1.0 + nrm(ks[8], (D,), 0.02),
        'w_ffn_in': nrm(ks[9], (DEPTH, D, 2 * F), D ** -0.5),
        'w_ffn_out': nrm(ks[10], (DEPTH, F, D), F ** -0.5),
        'rg_w_in': nrm(ks[11], (N_RG, D, 2 * W), D ** -0.5),
        'rg_conv_w': nrm(ks[12], (N_RG, RG_CONV, W), RG_CONV ** -0.5),
        'rg_conv_b': nrm(ks[13], (N_RG, W), 0.01),
        'rg_w_a': nrm(ks[15], (N_RG, 2, RG_HEADS, RG_HEAD_DIM, RG_HEAD_DIM), RG_HEAD_DIM ** -0.5),
        'rg_b_a': nrm(ks[16], (N_RG, 2, RG_HEADS, RG_HEAD_DIM), 0.01),
        'rg_w_i': nrm(ks[17], (N_RG, 2, RG_HEADS, RG_HEAD_DIM, RG_HEAD_DIM), RG_HEAD_DIM ** -0.5),
        'rg_b_i': nrm(ks[18], (N_RG, 2, RG_HEADS, RG_HEAD_DIM), 0.01),
        'rg_lam': jnp.log(s) - jnp.log1p(-s),
        'rg_w_out': nrm(ks[19], (N_RG, W, D), W ** -0.5),
        'hg_w_in': nrm(ks[20], (N_HG, D, 5 * D), D ** -0.5),
        'hg_lb': nrm(ks[21], (DEPTH, 2, HG_HEADS * HG_DK), 0.1),
        'hg_norm': 1.0 + nrm(ks[22], (N_HG, HG_DV), 0.02),
        'hg_w_out': nrm(ks[23], (N_HG, HG_HEADS * HG_DV, D), D ** -0.5),
    }


def reference(x, c, ctx, c_ctx, w_ada, b_ada, g_mix, g_ffn, g_final, w_ffn_in, w_ffn_out,
              rg_w_in, rg_conv_w, rg_conv_b, rg_w_a, rg_b_a, rg_w_i, rg_b_i, rg_lam, rg_w_out,
              hg_w_in, hg_lb, hg_norm, hg_w_out):
    rows = x.shape[1] // GRID_W
    lb_all = jnp.cumsum(jax.nn.softmax(hg_lb.astype(jnp.float32), axis=0), axis=0)
    xl, xc = x, ctx
    for i in range(DEPTH):
        last = i == DEPTH - 1
        sh1, sc1, ga1, sh2, sc2, ga2 = _ada(c, w_ada[i], b_ada[i])
        csh1, csc1, cga1, csh2, csc2, cga2 = _ada(c_ctx[None, :], w_ada[i], b_ada[i])
        hl = _modulate(xl, g_mix[i], sh1, sc1)
        hc = _modulate(xc, g_mix[i], csh1, csc1)
        j = i // N_MIXERS
        if i % N_MIXERS == 0:
            yc, yl = _rglru_mixer(hc, hl, rg_w_in[j], rg_conv_w[j], rg_conv_b[j], rg_w_a[j], rg_b_a[j],
                                  rg_w_i[j], rg_b_i[j], rg_lam[j], rg_w_out[j], not last)
        else:
            lb = (lb_all[i] - lb_all[0]).reshape(2, HG_HEADS, HG_DK)
            yc, yl = _hgrn2_mixer(hc, _to_col_major(hl, rows), hg_w_in[j], lb, hg_norm[j], hg_w_out[j], not last)
            yl = _from_col_major(yl, rows)
        xl = xl + ga1 * yl
        xl = xl + ga2 * _swiglu(_modulate(xl, g_ffn[i], sh2, sc2), w_ffn_in[i], w_ffn_out[i])
        if not last:
            xc = xc + cga1 * yc
            xc = xc + cga2 * _swiglu(_modulate(xc, g_ffn[i], csh2, csc2), w_ffn_in[i], w_ffn_out[i])
    return _rms(xl, g_final)
```

```cpp
#include <hip/hip_runtime.h>
#include <hip/hip_cooperative_groups.h>
#include <cstdio>
namespace cg = cooperative_groups;
namespace pg8 {
#define PG8_LAS __attribute__((address_space(3)))
typedef unsigned short bf16_t;
typedef short bf16x8 __attribute__((ext_vector_type(8)));
typedef float f32x4 __attribute__((ext_vector_type(4)));
typedef unsigned u32x4 __attribute__((ext_vector_type(4)));
constexpr int BM = 256, BK = 64, HALF = 128, HTB = HALF * BK * 2  , STAGE_BYTES = 8 * HTB, NXCD = 8, WGM = 4;

__host__ __device__ __forceinline__ int lds_byte(int r, int c) { const int st = (r >> 4) * 2 + (c >> 5), rr = r & 15, cc = c & 31, ob = rr * 64 + cc * 2; return st * 1024 + (ob ^ (((ob >> 9) & 1) << 5)); }
__host__ __device__ __forceinline__ void stage_rc(int b, int& R, int& C) { const int st = b / 1024, sb = b % 1024, swz = sb ^ (((sb >> 9) & 1) << 5); R = (st >> 1) * 16 + swz / 64; C = (st & 1) * 32 + (swz % 64) / 2; }
__host__ __device__ __forceinline__ int perm32(int rho) { const int n = rho >> 4, i = rho & 15; return 8 * (i >> 2) + 4 * n + (i & 3); }

struct Unit { int pm, pn; };
struct Gemm { const bf16_t* A; const bf16_t* Bt; int M, N, K, ld; };

struct StaticOrder {
    int nM, nN, nwg, G, c;
    __host__ __device__ void init(int M, int N, int G_, int c_) { nM = M / BM; nN = N / BM; nwg = nM * nN; G = G_; c = c_; }
    __host__ __device__ bool next(int i, Unit& u) const {
        const long L = (long)i * G + c; if (L >= nwg) return false;
        int wgid = (int)L; { const int q = nwg / NXCD, r = nwg % NXCD, xcd = wgid % NXCD, off = wgid / NXCD; wgid = (xcd < r ? xcd * (q + 1) : r * (q + 1) + (xcd - r) * q) + off; }
        const int nig = WGM * nN, gid = wgid / nig, fm = gid * WGM, gsz = (nM - fm) < WGM ? (nM - fm) : WGM;
        u.pm = fm + ((wgid % nig) % gsz); u.pn = (wgid % nig) / gsz; return true;
    }
    __device__ __forceinline__ void a_ready(const Unit&) const {}
    __device__ __forceinline__ void done(const Unit&) const {}
};
typedef __bf16 bf16v2_t __attribute__((ext_vector_type(2)));
typedef float f32x2v_t __attribute__((ext_vector_type(2)));
__device__ __forceinline__ unsigned cvt_pk_bf16(float lo, float hi) { const f32x2v_t v = {lo, hi}; const bf16v2_t r = __builtin_convertvector(v, bf16v2_t); return __builtin_bit_cast(unsigned, r); }
template <class Epi, class Sched, bool ALIGN_EPI = false, bool SP2 = false>
__device__ __forceinline__ void gemm_phase(PG8_LAS unsigned char* lds, const Gemm g, const Sched& S, const Epi& E) {
    int tid_ = threadIdx.x; asm volatile("" : "+v"(tid_)); const int tid = tid_, wid = __builtin_amdgcn_readfirstlane(tid >> 6), lane = tid & 63, wr = wid >> 2, wc = wid & 3, fr = lane & 15, fq = lane >> 4;
    const int K = g.ld, nt = g.K / BK;
    unsigned voffA[2], voffB[2];
#pragma unroll
    for (int i = 0; i < 2; ++i) { int R, C; stage_rc(tid * 16 + i * 8192, R, C); const int Rb = Epi::PERM ? ((R & ~31) + perm32(R & 31)) : R;
        voffA[i] = (unsigned)(R * K + C) * 2u; voffB[i] = (unsigned)(Rb * K + C) * 2u; }
    const size_t kstep = (size_t)(BK * 2);
    const size_t hstep = (size_t)HALF * K * 2;
    const size_t tstep = 2 * hstep;
    const unsigned ldsw = (unsigned)wid * 1024u;
    const int aoff = lds_byte(wr * 64 + fr, fq * 8), boff = lds_byte(wc * 32 + fr, fq * 8);
#define PG8_SA(b, h) (((b) * 2 + (h)) * HTB)
#define PG8_SB(b, h) ((4 + (b) * 2 + (h)) * HTB)
#define PG8_STAGE(bufoff, gbase, voff) do { _Pragma("unroll") for (int _i = 0; _i < 2; ++_i) \
        __builtin_amdgcn_global_load_lds((const unsigned*)((const char*)(gbase) + (voff)[_i]), (PG8_LAS unsigned*)(lds + (bufoff) + ldsw + _i * 8192), 16, 0, 0); } while (0)
#define PG8_LDA(dst, b, h) do { _Pragma("unroll") for (int m = 0; m < 4; ++m) _Pragma("unroll") for (int k = 0; k < 2; ++k) dst[m][k] = *(const PG8_LAS bf16x8*)(lds + PG8_SA(b, h) + aoff + m * 2048 + k * 1024); } while (0)
#define PG8_LDB(dst, b, h) do { _Pragma("unroll") for (int n = 0; n < 2; ++n) _Pragma("unroll") for (int k = 0; k < 2; ++k) dst[n][k] = *(const PG8_LAS bf16x8*)(lds + PG8_SB(b, h) + boff + n * 2048 + k * 1024); } while (0)
#define PG8_MMA(ai, bj, At, Bt) do { __builtin_amdgcn_s_setprio(1); _Pragma("unroll") for (int m = 0; m < 4; ++m) _Pragma("unroll") for (int n = 0; n < 2; ++n) _Pragma("unroll") for (int k = 0; k < 2; ++k) \
        acc[ai][bj][m][n] = __builtin_amdgcn_mfma_f32_16x16x32_bf16(Bt[n][k], At[m][k], acc[ai][bj][m][n], 0, 0, 0); __builtin_amdgcn_s_setprio(0); } while (0)
#define PG8_WAIT_V(n) asm volatile("s_waitcnt vmcnt(" #n ")" ::: "memory")
#define PG8_WAIT_L(n) asm volatile("s_waitcnt lgkmcnt(" #n ")" ::: "memory")
#define PG8_BAR __builtin_amdgcn_s_barrier()
#define PG8_SCHED __builtin_amdgcn_sched_barrier(0)
    Unit cur, nxt; int ui = 0;
    if (!S.next(0, cur)) return;
    f32x4 acc[2][2][4][2];
#pragma unroll
    for (int a = 0; a < 2; ++a)
#pragma unroll
        for (int b = 0; b < 2; ++b)
#pragma unroll
            for (int m = 0; m < 4; ++m)
#pragma unroll
                for (int n = 0; n < 2; ++n) acc[a][b][m][n] = (f32x4){0.f, 0.f, 0.f, 0.f};
    bf16x8 At[4][2], B0[2][2], B1[2][2];
    const char* cA = (const char*)g.A + (size_t)cur.pm * tstep; const char* cB = (const char*)g.Bt + (size_t)cur.pn * tstep;
    S.a_ready(cur);
    if constexpr (SP2) {
        PG8_STAGE(PG8_SB(0, 0), cB, voffB); PG8_STAGE(PG8_SB(0, 1), cB + hstep, voffB); PG8_STAGE(PG8_SA(0, 0), cA, voffA); PG8_STAGE(PG8_SA(0, 1), cA + hstep, voffA);
        if (wr == 1) PG8_BAR;
        PG8_WAIT_V(2); PG8_BAR;
        PG8_STAGE(PG8_SB(1, 0), cB + kstep, voffB); PG8_STAGE(PG8_SA(1, 0), cA + kstep, voffA); PG8_STAGE(PG8_SB(1, 1), cB + hstep + kstep, voffB);
        PG8_WAIT_V(6); PG8_BAR;
    } else {
        PG8_STAGE(PG8_SB(0, 0), cB, voffB); PG8_STAGE(PG8_SA(0, 0), cA, voffA); PG8_STAGE(PG8_SB(0, 1), cB + hstep, voffB); PG8_STAGE(PG8_SA(0, 1), cA + hstep, voffA);
        if (wr == 1) PG8_BAR;
        PG8_WAIT_V(4); PG8_BAR;
        PG8_STAGE(PG8_SB(1, 0), cB + kstep, voffB); PG8_STAGE(PG8_SA(1, 0), cA + kstep, voffA); PG8_STAGE(PG8_SB(1, 1), cB + hstep + kstep, voffB);
        PG8_WAIT_V(6); PG8_BAR;
    }
    for (;;) {
        const bool has_next = S.next(ui + 1, nxt);
        const char* nA = has_next ? (const char*)g.A + (size_t)nxt.pm * tstep : cA; const char* nB = has_next ? (const char*)g.Bt + (size_t)nxt.pn * tstep : cB;
        for (int t = 0; t < nt; t += 2) {
            const bool last = (t == nt - 2);
            const char* a1 = cA + (size_t)(t + 1) * kstep;
            const char* a2 = last ? nA : cA + (size_t)(t + 2) * kstep; const char* b2 = last ? nB : cB + (size_t)(t + 2) * kstep;
            const char* a3 = a2 + kstep; const char* b3 = b2 + kstep;
            if (last && has_next) S.a_ready(nxt);
            if constexpr (SP2) {
            PG8_LDB(B0, 0, 0); PG8_LDB(B1, 0, 1); PG8_SCHED; PG8_LDA(At, 0, 0); PG8_STAGE(PG8_SA(1, 1), a1 + hstep, voffA);
            PG8_WAIT_V(8); PG8_WAIT_L(0); PG8_BAR; PG8_MMA(0, 0, At, B0); PG8_MMA(0, 1, At, B1); PG8_BAR; PG8_SCHED;
            PG8_LDA(At, 0, 1); PG8_STAGE(PG8_SB(0, 0), b2, voffB); PG8_STAGE(PG8_SB(0, 1), b2 + hstep, voffB); PG8_STAGE(PG8_SA(0, 0), a2, voffA);
            PG8_WAIT_V(8); PG8_WAIT_L(0); PG8_BAR; PG8_MMA(1, 0, At, B0); PG8_MMA(1, 1, At, B1); PG8_BAR; PG8_SCHED;
            PG8_LDB(B0, 1, 0); PG8_LDB(B1, 1, 1); PG8_SCHED; PG8_LDA(At, 1, 0); PG8_STAGE(PG8_SA(0, 1), a2 + hstep, voffA);
            PG8_WAIT_V(8); PG8_WAIT_L(0); PG8_BAR; PG8_MMA(0, 0, At, B0); PG8_MMA(0, 1, At, B1); PG8_BAR; PG8_SCHED;
            PG8_LDA(At, 1, 1); PG8_STAGE(PG8_SB(1, 0), b3, voffB); PG8_STAGE(PG8_SB(1, 1), b3 + hstep, voffB); PG8_STAGE(PG8_SA(1, 0), a3, voffA);
            PG8_WAIT_V(8); PG8_WAIT_L(0); PG8_BAR; PG8_MMA(1, 0, At, B0); PG8_MMA(1, 1, At, B1); PG8_BAR; PG8_SCHED;
            } else {
            PG8_LDB(B0, 0, 0); PG8_SCHED; PG8_LDA(At, 0, 0); PG8_STAGE(PG8_SA(1, 1), a1 + hstep, voffA);
            PG8_WAIT_L(8); PG8_BAR; PG8_WAIT_L(0); PG8_MMA(0, 0, At, B0); PG8_BAR; PG8_SCHED;
            PG8_LDB(B1, 0, 1); PG8_STAGE(PG8_SB(0, 0), b2, voffB);
            PG8_BAR; PG8_WAIT_L(0); PG8_MMA(0, 1, At, B1); PG8_BAR;
            PG8_LDA(At, 0, 1); PG8_STAGE(PG8_SA(0, 0), a2, voffA);
            PG8_BAR; PG8_WAIT_L(0); PG8_MMA(1, 0, At, B0); PG8_BAR; PG8_SCHED;
            PG8_STAGE(PG8_SB(0, 1), b2 + hstep, voffB);
            PG8_WAIT_V(6); PG8_BAR; PG8_MMA(1, 1, At, B1); PG8_BAR;
            PG8_LDB(B0, 1, 0); PG8_SCHED; PG8_LDA(At, 1, 0); PG8_STAGE(PG8_SA(0, 1), a2 + hstep, voffA);
            PG8_WAIT_L(8); PG8_BAR; PG8_WAIT_L(0); PG8_MMA(0, 0, At, B0); PG8_BAR; PG8_SCHED;
            PG8_LDB(B1, 1, 1); PG8_STAGE(PG8_SB(1, 0), b3, voffB);
            PG8_BAR; PG8_WAIT_L(0); PG8_MMA(0, 1, At, B1); PG8_BAR;
            PG8_LDA(At, 1, 1); PG8_STAGE(PG8_SA(1, 0), a3, voffA);
            PG8_BAR; PG8_WAIT_L(0); PG8_MMA(1, 0, At, B0); PG8_BAR; PG8_SCHED;
            PG8_STAGE(PG8_SB(1, 1), b3 + hstep, voffB);
            PG8_WAIT_V(6); PG8_BAR; PG8_MMA(1, 1, At, B1); PG8_BAR;
            }
        }
        if constexpr (ALIGN_EPI) { if (wr == 0) PG8_BAR; }
        if constexpr (!Epi::AFTER_DRAIN) { E(acc, cur, wr, wc, fr, fq); S.done(cur); }
        if (!has_next) break;
#pragma unroll
        for (int a = 0; a < 2; ++a)
#pragma unroll
            for (int b = 0; b < 2; ++b)
#pragma unroll
                for (int m = 0; m < 4; ++m)
#pragma unroll
                    for (int n = 0; n < 2; ++n) acc[a][b][m][n] = (f32x4){0.f, 0.f, 0.f, 0.f};
        cur = nxt; cA = nA; cB = nB; ++ui;
        if constexpr (ALIGN_EPI) { if (wr == 1) PG8_BAR; }
    }
    PG8_WAIT_V(0);
    if constexpr (!ALIGN_EPI) { if (wr == 0) PG8_BAR; }
    PG8_BAR;
    if constexpr (Epi::AFTER_DRAIN) { E.fused(acc, cur, wr, wc, fr, fq, lds, wid, lane); S.done(cur); }
#undef PG8_SA
#undef PG8_SB
#undef PG8_STAGE
#undef PG8_LDA
#undef PG8_LDB
#undef PG8_MMA
#undef PG8_WAIT_V
#undef PG8_WAIT_L
#undef PG8_BAR
#undef PG8_SCHED
}
}


using pg8::bf16_t; using pg8::bf16x8; using pg8::f32x4; using pg8::u32x4; using pg8::Unit; using pg8::cvt_pk_bf16;
#define LAS __attribute__((address_space(3)))
typedef unsigned u32x2 __attribute__((ext_vector_type(2)));

constexpr int D = 2048, NB = 8, SEQ = 2048, CTXL = 256, FF = 5632;
constexpr int ML = NB * SEQ, MC = NB * CTXL, MT = ML + MC;
constexpr size_t MiB = 1048576;
constexpr size_t OFF_WRGIN = 0, OFF_WRGOUT = 16 * MiB, OFF_WFFNIN0 = 24 * MiB, OFF_WFFNIN1 = 68 * MiB, OFF_WFFNOUT0 = 112 * MiB, OFF_WFFNOUT1 = 134 * MiB,
                 OFF_WHGIN = 156 * MiB, OFF_WHGOUT = 196 * MiB, OFF_A0 = 204 * MiB, OFF_HB = 276 * MiB, OFF_BIG = 348 * MiB, OFF_XC = 708 * MiB, OFF_MOD = 724 * MiB,
                 OFF_BAR = 724 * MiB + 917504, OFF_PART = OFF_BIG + 208 * MiB  , WS_END = 725 * MiB;
constexpr int LDS_BYTES = 144 * 1024;
constexpr bool GEMM_ALIGN = true, GEMM_SP2 = true;

struct Params { const float* in[24]; float* out; unsigned char* ws; };
enum { I_X = 0, I_C, I_CTX, I_CCTX, I_WADA, I_BADA, I_GMIX, I_GFFN, I_GFINAL, I_WFFNIN, I_WFFNOUT, I_RGWIN, I_RGCONVW, I_RGCONVB, I_RGWA, I_RGBA, I_RGWI, I_RGBI, I_RGLAM,
       I_RGWOUT, I_HGWIN, I_HGLB, I_HGNORM, I_HGWOUT };

__device__ __forceinline__ int opaque_tid() { int t = threadIdx.x; asm volatile("" : "+v"(t)); return t; }
__device__ __forceinline__ float bf2f(unsigned v) { return __uint_as_float(v << 16); }
__device__ __forceinline__ float bflo(unsigned w) { return __uint_as_float(w << 16); }
__device__ __forceinline__ float bfhi(unsigned w) { return __uint_as_float(w & 0xffff0000u); }
__device__ __forceinline__ float frcp(float x) { return __builtin_amdgcn_rcpf(x); }
__device__ __forceinline__ float fexp2(float x) { return __builtin_amdgcn_exp2f(x); }
__device__ __forceinline__ float sigm(float x) { return frcp(1.0f + fexp2(-1.4426950408889634f * x)); }
__device__ __forceinline__ float silu_f(float x) { return x * frcp(1.0f + fexp2(-1.4426950408889634f * x)); }
__device__ __forceinline__ float gelu_tanh_f(float x) { const float u = 0.7978845608028654f * (x + 0.044715f * x * x * x); return x * frcp(1.0f + fexp2(-2.8853900817779268f * u)); }
template <int CTRL> __device__ __forceinline__ float dpp_f(float oldv, float src) { return __int_as_float(__builtin_amdgcn_update_dpp(__float_as_int(oldv), __float_as_int(src), CTRL, 0xf, 0xf, false)); }
__device__ __forceinline__ bf16_t f2bf(float f) { return (bf16_t)(cvt_pk_bf16(f, 0.f) & 0xffffu); }

__device__ __forceinline__ void conv_job(const Params& p, int tile, const float*& W, bf16_t*& Wt, int& K, int& N, int& mode, int& local) {
    bf16_t* ws = (bf16_t*)p.ws;
    if (tile < 1024)       { W = p.in[I_RGWIN]; Wt = (bf16_t*)(p.ws + OFF_WRGIN); K = 2048; N = 4096; mode = 0; local = tile; }
    else if (tile < 1536)  { W = p.in[I_RGWOUT]; Wt = (bf16_t*)(p.ws + OFF_WRGOUT); K = 2048; N = 2048; mode = 0; local = tile - 1024; }
    else if (tile < 4352)  { W = p.in[I_WFFNIN]; Wt = (bf16_t*)(p.ws + OFF_WFFNIN0); K = 2048; N = 11264; mode = 1; local = tile - 1536; }
    else if (tile < 7168)  { W = p.in[I_WFFNIN] + (size_t)2048 * 11264; Wt = (bf16_t*)(p.ws + OFF_WFFNIN1); K = 2048; N = 11264; mode = 1; local = tile - 4352; }
    else if (tile < 8576)  { W = p.in[I_WFFNOUT]; Wt = (bf16_t*)(p.ws + OFF_WFFNOUT0); K = 5632; N = 2048; mode = 0; local = tile - 7168; }
    else if (tile < 9984)  { W = p.in[I_WFFNOUT] + (size_t)5632 * 2048; Wt = (bf16_t*)(p.ws + OFF_WFFNOUT1); K = 5632; N = 2048; mode = 0; local = tile - 8576; }
    else if (tile < 12544) { W = p.in[I_HGWIN]; Wt = (bf16_t*)(p.ws + OFF_WHGIN); K = 2048; N = 10240; mode = 0; local = tile - 9984; }
    else                   { W = p.in[I_HGWOUT]; Wt = (bf16_t*)(p.ws + OFF_WHGOUT); K = 2048; N = 2048; mode = 0; local = tile - 12544; }
    (void)ws;
}
constexpr int N_CONV_TILES = 13056;

__device__ __forceinline__ void convert_range(const Params& p, LAS unsigned char* lds, int first, int last, int w, int nw) {
    const int tid = opaque_tid();
    LAS float* st = (LAS float*)lds;
    const int col4 = tid & 15, krow = tid >> 4;
    const int nn = tid & 63, kg = tid >> 6;
    f32x4 rg[4];
    int tile = first + w;
    if (tile < last) {
        const float* W; bf16_t* Wt; int K, N, mode, local; conv_job(p, tile, W, Wt, K, N, mode, local);
        const int ntn = N >> 6, k0 = (local / ntn) * 128, n0 = (local % ntn) * 64;
#pragma unroll
        for (int ps = 0; ps < 4; ++ps) rg[ps] = __builtin_nontemporal_load((const f32x4*)(W + (size_t)(k0 + krow + 32 * ps) * N + n0 + col4 * 4));
    }
    for (; tile < last; tile += nw) {
        const float* W; bf16_t* Wt; int K, N, mode, local; conv_job(p, tile, W, Wt, K, N, mode, local);
        const int ntn = N >> 6, k0 = (local / ntn) * 128, n0 = (local % ntn) * 64;
#pragma unroll
        for (int ps = 0; ps < 4; ++ps) *(LAS f32x4*)(st + (krow + 32 * ps) * 68 + col4 * 4) = rg[ps];
        __syncthreads();
        const int nt2 = tile + nw;
        if (nt2 < last) {
            const float* W2; bf16_t* Wt2; int K2, N2, mode2, local2; conv_job(p, nt2, W2, Wt2, K2, N2, mode2, local2);
            const int ntn2 = N2 >> 6, k02 = (local2 / ntn2) * 128, n02 = (local2 % ntn2) * 64;
#pragma unroll
            for (int ps = 0; ps < 4; ++ps) rg[ps] = __builtin_nontemporal_load((const f32x4*)(W2 + (size_t)(k02 + krow + 32 * ps) * N2 + n02 + col4 * 4));
        }
        int c = n0 + nn, dest = c;
        if (mode == 1) { const int half = c >= FF ? 1 : 0; const int j = c - half * FF; dest = (j >> 7) * 256 + half * 128 + (j & 127); }
#pragma unroll
        for (int ps = 0; ps < 2; ++ps) {
            const int kgrp = kg + 8 * ps;
            float v[8];
#pragma unroll
            for (int j = 0; j < 8; ++j) v[j] = st[(kgrp * 8 + j) * 68 + nn];
            u32x4 wv; wv.x = cvt_pk_bf16(v[0], v[1]); wv.y = cvt_pk_bf16(v[2], v[3]); wv.z = cvt_pk_bf16(v[4], v[5]); wv.w = cvt_pk_bf16(v[6], v[7]);
            *(u32x4*)(Wt + (size_t)dest * K + k0 + kgrp * 8) = wv;
        }
        __syncthreads();
    }
}

__device__ __forceinline__ void prep_phase(const Params& p, LAS unsigned char* lds) {
    const int tid = opaque_tid();
    {
        LAS float* sl = (LAS float*)lds;
        LAS float* red = (LAS float*)(lds + 73728);
        for (int idx = tid; idx < 9 * 2048; idx += 512) { const int i = idx >> 11, k = idx & 2047; const float v = (i < 8) ? p.in[I_C][i * 2048 + k] : p.in[I_CCTX][k]; sl[idx] = silu_f(v); }
        __syncthreads();
        float* mod = (float*)(p.ws + OFF_MOD);
        for (int g = blockIdx.x; g < 256; g += gridDim.x) {
            const int gc = g * 96, l = gc / 12288, n0 = gc % 12288;
            if (tid < 384) {
                const int cg4 = tid % 24, kl = tid / 24;
                f32x4 acc[9];
#pragma unroll
                for (int i = 0; i < 9; ++i) acc[i] = (f32x4){0.f, 0.f, 0.f, 0.f};
                const float* wp = p.in[I_WADA] + ((size_t)l * 2048 + kl) * 12288 + n0 + cg4 * 4;
#pragma unroll 8
                for (int kk = 0; kk < 128; ++kk) {
                    const f32x4 w = __builtin_nontemporal_load((const f32x4*)(wp + (size_t)kk * 16 * 12288));
                    const int k = kl + 16 * kk;
#pragma unroll
                    for (int i = 0; i < 9; ++i) { const float s = sl[i * 2048 + k]; acc[i] += w * s; }
                }
#pragma unroll
                for (int i = 0; i < 9; ++i) *(LAS f32x4*)(red + (kl * 9 + i) * 96 + cg4 * 4) = acc[i];
            }
            __syncthreads();
            for (int o = tid; o < 864; o += 512) {
                const int i = o / 96, col = o % 96; float s = 0.f;
#pragma unroll
                for (int kl = 0; kl < 16; ++kl) s += red[(kl * 9 + i) * 96 + col];
                mod[(size_t)(l * 9 + i) * 12288 + n0 + col] = s + p.in[I_BADA][l * 12288 + n0 + col];
            }
            __syncthreads();
        }
    }
    convert_range(p, lds, 0, N_CONV_TILES, (int)blockIdx.x, (int)gridDim.x);
}

__device__ __forceinline__ float wave_sum(float v) {
#pragma unroll
    for (int o = 32; o >= 1; o >>= 1) v += __shfl_xor(v, o);
    return v;
}
__device__ __forceinline__ void mod_phase(const Params& p, int layer, int which, int nrows, int src_mode, const float* part = nullptr, const float* rin_ctx = nullptr, const float* gate_ctx = nullptr) {
    const int tid = opaque_tid(); const int lane = tid & 63, wave = blockIdx.x * 8 + (tid >> 6), nw = gridDim.x * 8;
    const float* g = (which ? p.in[I_GFFN] : p.in[I_GMIX]) + layer * 2048;
    const float* mod = (const float*)(p.ws + OFF_MOD);
    bf16_t* A0 = (bf16_t*)(p.ws + OFF_A0);
    const float* lat = src_mode ? p.out : p.in[I_X];
    const float* ctx = src_mode ? (const float*)(p.ws + OFF_XC) : p.in[I_CTX];
    f32x4 mg[8];
#pragma unroll
    for (int j = 0; j < 8; ++j) mg[j] = *(const f32x4*)(g + lane * 4 + 256 * j);
    f32x4 vn[8];
    int r = wave;
    bool have = (r < nrows) && !(part != nullptr && r >= ML);
    if (have) { const float* src = (r < ML) ? lat + (size_t)r * 2048 : ctx + (size_t)(r - ML) * 2048;
#pragma unroll
        for (int j = 0; j < 8; ++j) vn[j] = __builtin_nontemporal_load((const f32x4*)(src + lane * 4 + 256 * j)); }
    for (; r < nrows; r += nw) {
        const int bi = (r < ML) ? (r >> 11) : 8;
        const float* sh = mod + (size_t)(layer * 9 + bi) * 12288 + (which ? 3 : 0) * 2048;
        const float* sc = sh + 2048;
        f32x4 v[8]; float ss = 0.f;
        if (have) {
#pragma unroll
            for (int j = 0; j < 8; ++j) v[j] = vn[j];
        } else {
            const size_t ro = (size_t)(r - ML) * 2048; float* xc = (float*)(p.ws + OFF_XC) + ro;
#pragma unroll
            for (int j = 0; j < 8; ++j) { const int col = lane * 4 + 256 * j;
                const f32x4 s4 = (*(const f32x4*)(part + ro + col) + *(const f32x4*)(part + (size_t)MC * 2048 + ro + col)) + (*(const f32x4*)(part + (size_t)2 * MC * 2048 + ro + col) + *(const f32x4*)(part + (size_t)3 * MC * 2048 + ro + col));
                v[j] = *(const f32x4*)(rin_ctx + ro + col) + *(const f32x4*)(gate_ctx + col) * s4;
                *(f32x4*)(xc + col) = v[j]; }
        }
        f32x4 m1[8], m0[8];
#pragma unroll
        for (int j = 0; j < 8; ++j) { const int col = lane * 4 + 256 * j; m1[j] = *(const f32x4*)(sc + col); m0[j] = *(const f32x4*)(sh + col); }
        { const int rn = r + nw; have = (rn < nrows) && !(part != nullptr && rn >= ML);
          if (have) { const float* src = (rn < ML) ? lat + (size_t)rn * 2048 : ctx + (size_t)(rn - ML) * 2048;
#pragma unroll
              for (int j = 0; j < 8; ++j) vn[j] = __builtin_nontemporal_load((const f32x4*)(src + lane * 4 + 256 * j)); } }
#pragma unroll
        for (int j = 0; j < 8; ++j) ss += v[j][0] * v[j][0] + v[j][1] * v[j][1] + v[j][2] * v[j][2] + v[j][3] * v[j][3];
        ss = wave_sum(ss);
        const float rstd = rsqrtf(ss * (1.0f / 2048.0f) + 1e-6f);
#pragma unroll
        for (int j = 0; j < 8; ++j) {
            const int col = lane * 4 + 256 * j;
            const f32x4 y = (v[j] * rstd) * mg[j] * (m1[j] + 1.0f) + m0[j];
            u32x2 w; w.x = cvt_pk_bf16(y[0], y[1]); w.y = cvt_pk_bf16(y[2], y[3]);
            *(u32x2*)(A0 + (size_t)r * 2048 + col) = w;
        }
    }
}

__device__ __forceinline__ void final_phase(const Params& p) {
    const int tid = opaque_tid(); const int lane = tid & 63, wave = blockIdx.x * 8 + (tid >> 6), nw = gridDim.x * 8;
    const float* g = p.in[I_GFINAL];
    f32x4 gg[8];
#pragma unroll
    for (int j = 0; j < 8; ++j) gg[j] = *(const f32x4*)(g + lane * 4 + 256 * j);
    for (int r = wave; r < ML; r += nw) {
        float* src = p.out + (size_t)r * 2048;
        f32x4 v[8]; float ss = 0.f;
#pragma unroll
        for (int j = 0; j < 8; ++j) { v[j] = __builtin_nontemporal_load((const f32x4*)(src + lane * 4 + 256 * j)); ss += v[j][0] * v[j][0] + v[j][1] * v[j][1] + v[j][2] * v[j][2] + v[j][3] * v[j][3]; }
        ss = wave_sum(ss);
        const float rstd = rsqrtf(ss * (1.0f / 2048.0f) + 1e-6f);
#pragma unroll
        for (int j = 0; j < 8; ++j) { const int col = lane * 4 + 256 * j; *(f32x4*)(src + col) = (v[j] * rstd) * gg[j]; }
    }
}

struct EpiBf16 {
    static constexpr bool PERM = true, AFTER_DRAIN = false;
    bf16_t* O; int ldc;
    __device__ __forceinline__ void operator()(const f32x4 (&acc)[2][2][4][2], const Unit& u, int wr, int wc, int fr, int fq) const {
        const int row0 = u.pm * 256 + wr * 64 + fr, col0 = u.pn * 256 + wc * 32 + 8 * fq;
#pragma unroll
        for (int ai = 0; ai < 2; ++ai)
#pragma unroll
            for (int m = 0; m < 4; ++m) { bf16_t* rowp = O + (size_t)(row0 + ai * 128 + m * 16) * ldc + col0;
#pragma unroll
                for (int bj = 0; bj < 2; ++bj) { const f32x4 v0 = acc[ai][bj][m][0], v1 = acc[ai][bj][m][1];
                    u32x4 w; w.x = cvt_pk_bf16(v0[0], v0[1]); w.y = cvt_pk_bf16(v0[2], v0[3]); w.z = cvt_pk_bf16(v1[0], v1[1]); w.w = cvt_pk_bf16(v1[2], v1[3]);
                    *(u32x4*)(rowp + bj * 128) = w; } }
    }
};
struct EpiSwiglu {
    static constexpr bool PERM = true, AFTER_DRAIN = false;
    bf16_t* O; int ldc;
    __device__ __forceinline__ void operator()(const f32x4 (&acc)[2][2][4][2], const Unit& u, int wr, int wc, int fr, int fq) const {
        const int row0 = u.pm * 256 + wr * 64 + fr, col0 = u.pn * 128 + wc * 32 + 8 * fq;
#pragma unroll
        for (int ai = 0; ai < 2; ++ai)
#pragma unroll
            for (int m = 0; m < 4; ++m) { bf16_t* rowp = O + (size_t)(row0 + ai * 128 + m * 16) * ldc + col0;
                const f32x4 g0 = acc[ai][0][m][0], g1 = acc[ai][0][m][1], u0 = acc[ai][1][m][0], u1 = acc[ai][1][m][1];
                float y[8];
#pragma unroll
                for (int j = 0; j < 4; ++j) { y[j] = silu_f(g0[j]) * u0[j]; y[4 + j] = silu_f(g1[j]) * u1[j]; }
                u32x4 w; w.x = cvt_pk_bf16(y[0], y[1]); w.y = cvt_pk_bf16(y[2], y[3]); w.z = cvt_pk_bf16(y[4], y[5]); w.w = cvt_pk_bf16(y[6], y[7]);
                *(u32x4*)rowp = w; }
    }
};
struct EpiResid {
    static constexpr bool PERM = false, AFTER_DRAIN = false;
    const float* in_lat; const float* in_ctx; float* out_lat; float* out_ctx; const float* gate;
    __device__ __forceinline__ void operator()(const f32x4 (&acc)[2][2][4][2], const Unit& u, int wr, int wc, int fr, int fq) const {
        const int row0 = u.pm * 256 + wr * 64 + fr, col0 = u.pn * 256 + wc * 32 + 4 * fq;
        const bool isl = u.pm < 64; const int bi = isl ? (u.pm >> 3) : 8;
        const float* gp = gate + (size_t)bi * 12288 + col0;
        f32x4 gv[2][2];
#pragma unroll
        for (int bj = 0; bj < 2; ++bj)
#pragma unroll
            for (int n = 0; n < 2; ++n) gv[bj][n] = *(const f32x4*)(gp + bj * 128 + n * 16);
        const float* ibase = (isl ? in_lat + (size_t)row0 * 2048 : in_ctx + (size_t)(row0 - ML) * 2048) + col0;
        float* obase = (isl ? out_lat + (size_t)row0 * 2048 : out_ctx + (size_t)(row0 - ML) * 2048) + col0;
#pragma unroll
        for (int ai = 0; ai < 2; ++ai) {
            f32x4 rv[4][2][2];
#pragma unroll
            for (int m = 0; m < 4; ++m)
#pragma unroll
                for (int bj = 0; bj < 2; ++bj)
#pragma unroll
                    for (int n = 0; n < 2; ++n) rv[m][bj][n] = *(const f32x4*)(ibase + (size_t)(ai * 128 + m * 16) * 2048 + bj * 128 + n * 16);
#pragma unroll
            for (int m = 0; m < 4; ++m)
#pragma unroll
                for (int bj = 0; bj < 2; ++bj)
#pragma unroll
                    for (int n = 0; n < 2; ++n) *(f32x4*)(obase + (size_t)(ai * 128 + m * 16) * 2048 + bj * 128 + n * 16) = rv[m][bj][n] + gv[bj][n] * acc[ai][bj][m][n];
        }
    }
};

struct SchedHgIn {
    pg8::StaticOrder lat; int G, c;
    __device__ void init(int G_, int c_) { lat.init(ML, 10240, G_, c_); G = G_; c = c_; }
    __device__ bool next(int i, Unit& u) const {
        const long L = (long)i * G + c;
        if (L < lat.nwg) return lat.next(i, u);
        const int r = (int)(L - lat.nwg); if (r >= 8 * 24) return false;
        u.pm = 64 + (r & 7); u.pn = 8 + (r >> 3); return true;
    }
    __device__ __forceinline__ void a_ready(const Unit&) const {}
    __device__ __forceinline__ void done(const Unit&) const {}
};
template <class Epi> __device__ __forceinline__ void run_gemm(LAS unsigned char* lds, const bf16_t* A, const bf16_t* Bt, int M, int N, int K, const Epi& E) {
    pg8::Gemm g; g.A = A; g.Bt = Bt; g.M = M; g.N = N; g.K = K; g.ld = K;
    pg8::StaticOrder S; S.init(M, N, (int)gridDim.x, (int)blockIdx.x);
    pg8::gemm_phase<Epi, pg8::StaticOrder, GEMM_ALIGN, GEMM_SP2>(lds, g, S, E);
}

struct SchedOne { int pm, pn; bool has;
    __device__ bool next(int i, Unit& u) const { if (i != 0 || !has) return false; u.pm = pm; u.pn = pn; return true; }
    __device__ __forceinline__ void a_ready(const Unit&) const {}
    __device__ __forceinline__ void done(const Unit&) const {} };
struct EpiPartial { static constexpr bool PERM = false, AFTER_DRAIN = false; float* P;
    __device__ __forceinline__ void operator()(const f32x4 (&acc)[2][2][4][2], const Unit& u, int wr, int wc, int fr, int fq) const {
        const int row0 = u.pm * 256 + wr * 64 + fr, col0 = u.pn * 256 + wc * 32 + 4 * fq;
#pragma unroll
        for (int ai = 0; ai < 2; ++ai)
#pragma unroll
            for (int m = 0; m < 4; ++m) { float* rowp = P + (size_t)(row0 + ai * 128 + m * 16) * 2048 + col0;
#pragma unroll
                for (int bj = 0; bj < 2; ++bj)
#pragma unroll
                    for (int n = 0; n < 2; ++n) *(f32x4*)(rowp + bj * 128 + n * 16) = acc[ai][bj][m][n]; } } };
__device__ __forceinline__ void splitk_ctx_gemm(LAS unsigned char* lds, const Params& p, const bf16_t* A, const bf16_t* Bt, int K) {
    const int c = (int)blockIdx.x, j = c >> 2, s = c & 3, Kq = K >> 2;
    pg8::Gemm g; g.A = A + (size_t)ML * K + (size_t)s * Kq; g.Bt = Bt + (size_t)s * Kq; g.M = MC; g.N = 2048; g.K = Kq; g.ld = K;
    SchedOne S; S.pm = j & 7; S.pn = j >> 3; S.has = c < 256;
    EpiPartial E; E.P = (float*)(p.ws + OFF_PART) + (size_t)s * MC * 2048;
    pg8::gemm_phase<EpiPartial, SchedOne, GEMM_ALIGN, GEMM_SP2>(lds, g, S, E);
}
__device__ __forceinline__ int rg_tok_row(int b, int dir, int s, int& tk, int& len, int& base) {
    if (s < CTXL) { tk = dir ? (CTXL - 1 - s) : s; len = CTXL; base = ML + b * CTXL; }
    else { const int s2 = s - CTXL; tk = dir ? (SEQ - 1 - s2) : s2; len = SEQ; base = b * SEQ; }
    return base + tk;
}
#define LDS_BARRIER() do { asm volatile("s_waitcnt lgkmcnt(0)" ::: "memory"); __builtin_amdgcn_s_barrier(); asm volatile("" ::: "memory"); } while (0)
__device__ __forceinline__ void rg_scan_phase(const Params& p, LAS unsigned char* lds) {
    const int tid = opaque_tid(), wid = tid >> 6, lane = tid & 63, fr = lane & 15, fq = lane >> 4;
    LAS bf16_t* sW = (LAS bf16_t*)lds;
    const bf16_t* XG = (const bf16_t*)(p.ws + OFF_BIG);
    for (int u = blockIdx.x; u < 256; u += gridDim.x) {
        const int b = u >> 5, h = (u >> 1) & 15, dir = u & 1;
        bf16_t* HO = (bf16_t*)(p.ws + (dir ? OFF_HB : OFF_A0));
        {
            const float* wa = p.in[I_RGWA] + (size_t)(dir * 16 + h) * 16384; const float* wi = p.in[I_RGWI] + (size_t)(dir * 16 + h) * 16384;
            for (int it = 0; it < 16; ++it) {
                const int idx = tid + 512 * it, mat = idx >> 12, rem = idx & 4095, e4 = rem >> 7, d = rem & 127;
                const f32x4 v = *(const f32x4*)((mat ? wi : wa) + d * 128 + e4 * 4);
#pragma unroll
                for (int j = 0; j < 4; ++j) sW[(mat * 128 + e4 * 4 + j) * 136 + d] = f2bf(v[j]);
            }
        }
        const int cch = 16 * wid + fr;
        const float ba = p.in[I_RGBA][(dir * 16 + h) * 128 + cch], bi_ = p.in[I_RGBI][(dir * 16 + h) * 128 + cch];
        const float nsp = -8.0f * 1.4426950408889634f * log1pf(expf(-p.in[I_RGLAM][dir * 2048 + h * 128 + cch]));
        float hc = 0.f;
        const int c8 = tid & 15;
        LAS float* sCW = (LAS float*)(lds + 69632 + 2 * 17408);
        for (int idx = tid; idx < 640; idx += 512) sCW[idx] = (idx < 512) ? p.in[I_RGCONVW][(idx >> 7) * 2048 + h * 128 + (idx & 127)] : p.in[I_RGCONVB][h * 128 + (idx - 512)];
        u32x4 xr[2][4];
#define RG_LOAD_TAPS(tile_) do { _Pragma("unroll") for (int ps = 0; ps < 2; ++ps) { const int i_ = (tid >> 4) + 32 * ps; int tk_, len_, base_; rg_tok_row(b, dir, (tile_) * 64 + i_, tk_, len_, base_); \
            _Pragma("unroll") for (int k = 0; k < 4; ++k) { const int tt_ = tk_ + k - 2; const bool ok_ = (tt_ >= 0) && (tt_ < len_); \
                xr[ps][k] = ok_ ? *(const u32x4*)(XG + (size_t)(base_ + (ok_ ? tt_ : tk_)) * 4096 + h * 128 + c8 * 8) : (u32x4){0u, 0u, 0u, 0u}; } } } while (0)
        RG_LOAD_TAPS(0);
        __syncthreads();
        for (int tile = 0; tile < 36; ++tile) {
            LAS bf16_t* sA = (LAS bf16_t*)(lds + 69632 + (tile & 1) * 17408);
#pragma unroll
            for (int ps = 0; ps < 2; ++ps) {
                const int i = (tid >> 4) + 32 * ps;
                float xc[8];
                { const f32x4 c0 = *(const LAS f32x4*)(sCW + 512 + c8 * 8), c1 = *(const LAS f32x4*)(sCW + 512 + c8 * 8 + 4);
                  xc[0] = c0[0]; xc[1] = c0[1]; xc[2] = c0[2]; xc[3] = c0[3]; xc[4] = c1[0]; xc[5] = c1[1]; xc[6] = c1[2]; xc[7] = c1[3]; }
#pragma unroll
                for (int k = 0; k < 4; ++k) { const u32x4 raw = xr[ps][k];
                    const f32x4 w0 = *(const LAS f32x4*)(sCW + k * 128 + c8 * 8), w1 = *(const LAS f32x4*)(sCW + k * 128 + c8 * 8 + 4);
                    xc[0] += w0[0] * bflo(raw.x); xc[1] += w0[1] * bfhi(raw.x); xc[2] += w0[2] * bflo(raw.y); xc[3] += w0[3] * bfhi(raw.y);
                    xc[4] += w1[0] * bflo(raw.z); xc[5] += w1[1] * bfhi(raw.z); xc[6] += w1[2] * bflo(raw.w); xc[7] += w1[3] * bfhi(raw.w); }
                u32x4 w; w.x = cvt_pk_bf16(xc[0], xc[1]); w.y = cvt_pk_bf16(xc[2], xc[3]); w.z = cvt_pk_bf16(xc[4], xc[5]); w.w = cvt_pk_bf16(xc[6], xc[7]);
                *(LAS u32x4*)(sA + i * 136 + c8 * 8) = w;
            }
            if (tile + 1 < 36) RG_LOAD_TAPS(tile + 1);
            LDS_BARRIER();
            f32x4 aR[4], aI[4];
#pragma unroll
            for (int tt = 0; tt < 4; ++tt) { aR[tt] = (f32x4){0.f, 0.f, 0.f, 0.f}; aI[tt] = (f32x4){0.f, 0.f, 0.f, 0.f}; }
#pragma unroll
            for (int kk = 0; kk < 4; ++kk) {
                const bf16x8 wa_f = *(const LAS bf16x8*)(sW + (16 * wid + fr) * 136 + kk * 32 + fq * 8);
                const bf16x8 wi_f = *(const LAS bf16x8*)(sW + (128 + 16 * wid + fr) * 136 + kk * 32 + fq * 8);
#pragma unroll
                for (int tt = 0; tt < 4; ++tt) { const bf16x8 xf = *(const LAS bf16x8*)(sA + (tt * 16 + fr) * 136 + kk * 32 + fq * 8);
                    aR[tt] = __builtin_amdgcn_mfma_f32_16x16x32_bf16(xf, wa_f, aR[tt], 0, 0, 0);
                    aI[tt] = __builtin_amdgcn_mfma_f32_16x16x32_bf16(xf, wi_f, aI[tt], 0, 0, 0); }
            }
            int tk0, len0, base0; const int rb0 = rg_tok_row(b, dir, tile * 64, tk0, len0, base0);
#pragma unroll
            for (int tt = 0; tt < 4; ++tt) {
                float Ap[4], Bp[4];
#pragma unroll
                for (int i = 0; i < 4; ++i) {
                    const int it = tt * 16 + 4 * fq + i;
                    const float xv = bf2f(sA[it * 136 + cch]);
                    const float r = sigm(aR[tt][i] + ba), ig = sigm(aI[tt][i] + bi_);
                    const float a = fexp2(nsp * r), bb = __builtin_amdgcn_sqrtf(fmaxf(1.0f - a * a, 0.f)) * ig * xv;
                    if (i == 0) { Ap[0] = a; Bp[0] = bb; } else { Ap[i] = Ap[i - 1] * a; Bp[i] = fmaf(a, Bp[i - 1], bb); }
                }
                float Ag = Ap[3], Bg = Bp[3];
                { const float ap = __shfl_up(Ag, 16), bp = __shfl_up(Bg, 16); if (fq >= 1) { Bg = fmaf(Ag, bp, Bg); Ag *= ap; } }
                { const float ap = __shfl_up(Ag, 32), bp = __shfl_up(Bg, 32); if (fq >= 2) { Bg = fmaf(Ag, bp, Bg); Ag *= ap; } }
                float Ae = __shfl_up(Ag, 16), Be = __shfl_up(Bg, 16); if (fq == 0) { Ae = 1.0f; Be = 0.f; }
                const float At = __shfl(Ag, fr + 48), Bt = __shfl(Bg, fr + 48);
                const float hin = fmaf(Ae, hc, Be);
                hc = fmaf(At, hc, Bt);
#pragma unroll
                for (int i = 0; i < 4; ++i) {
                    const int it = tt * 16 + 4 * fq + i; const int row = rb0 + (dir ? -it : it);
                    HO[(size_t)row * 2048 + h * 128 + cch] = f2bf(fmaf(Ap[i], hin, Bp[i]));
                }
            }
        }
        __syncthreads();
    }
}
__device__ __forceinline__ void rg_combine_phase(const Params& p) {
    bf16_t* HF = (bf16_t*)(p.ws + OFF_A0); const bf16_t* HB = (const bf16_t*)(p.ws + OFF_HB); const bf16_t* XG = (const bf16_t*)(p.ws + OFF_BIG);
    const size_t n8 = (size_t)MT * 256, gsz = (size_t)gridDim.x * 512;
    const int tid = opaque_tid();
    for (size_t i0 = (size_t)blockIdx.x * 512 + tid; i0 < n8; i0 += gsz * 4) {
        u32x4 a[4], bq[4], gq[4];
#pragma unroll
        for (int k = 0; k < 4; ++k) { const size_t i = i0 + k * gsz; if (i < n8) { const size_t r = i >> 8; const int c = (int)(i & 255) * 8;
            a[k] = __builtin_nontemporal_load((const u32x4*)(HF + r * 2048 + c)); bq[k] = __builtin_nontemporal_load((const u32x4*)(HB + r * 2048 + c)); gq[k] = __builtin_nontemporal_load((const u32x4*)(XG + r * 4096 + 2048 + c)); } }
#pragma unroll
        for (int k = 0; k < 4; ++k) { const size_t i = i0 + k * gsz; if (i < n8) { const size_t r = i >> 8; const int c = (int)(i & 255) * 8;
            u32x4 w;
            w.x = cvt_pk_bf16((bflo(a[k].x) + bflo(bq[k].x)) * gelu_tanh_f(bflo(gq[k].x)), (bfhi(a[k].x) + bfhi(bq[k].x)) * gelu_tanh_f(bfhi(gq[k].x)));
            w.y = cvt_pk_bf16((bflo(a[k].y) + bflo(bq[k].y)) * gelu_tanh_f(bflo(gq[k].y)), (bfhi(a[k].y) + bfhi(bq[k].y)) * gelu_tanh_f(bfhi(gq[k].y)));
            w.z = cvt_pk_bf16((bflo(a[k].z) + bflo(bq[k].z)) * gelu_tanh_f(bflo(gq[k].z)), (bfhi(a[k].z) + bfhi(bq[k].z)) * gelu_tanh_f(bfhi(gq[k].z)));
            w.w = cvt_pk_bf16((bflo(a[k].w) + bflo(bq[k].w)) * gelu_tanh_f(bflo(gq[k].w)), (bfhi(a[k].w) + bfhi(bq[k].w)) * gelu_tanh_f(bfhi(gq[k].w)));
            *(u32x4*)(HF + r * 2048 + c) = w; } }
    }
}

__device__ __forceinline__ int hg_tok_row(int b, int dir, int s) {
    if (s < CTXL) return ML + b * CTXL + (dir ? (CTXL - 1 - s) : s);
    int i = s - CTXL; if (dir) i = SEQ - 1 - i;
    const int w = i >> 5, r = i & 31;
    return b * SEQ + r * 64 + w;
}
__device__ __forceinline__ bf16x8 as_bf16x8(u32x4 v) { return __builtin_bit_cast(bf16x8, v); }
__device__ __forceinline__ void hg_scan_mfma(const Params& p, LAS unsigned char* lds) {
    const int tid = opaque_tid(), wid = tid >> 6, lane = tid & 63, fr = lane & 15, fq = lane >> 4;
    const bf16_t* QF = (const bf16_t*)(p.ws + OFF_BIG);
    constexpr int BUFB = 38400;
    for (int u = blockIdx.x; u < 256; u += gridDim.x) {
        const int b = u >> 5, h = (u >> 1) & 15, dir = u & 1;
        bf16_t* OO = (bf16_t*)(p.ws + (dir ? OFF_HB : OFF_A0));
        const int dch = 16 * wid + fr;
        const float lb = sigm(p.in[I_HGLB][4096 + dir * 2048 + h * 128 + dch] - p.in[I_HGLB][dir * 2048 + h * 128 + dch]);
        f32x4 S[8];
#pragma unroll
        for (int T = 0; T < 8; ++T) S[T] = (f32x4){0.f, 0.f, 0.f, 0.f};
        unsigned rq[8], rz[8], rv[8];
        unsigned rbo[8];
#pragma unroll
        for (int t = 0; t < 8; ++t) { const int rr = 8 * fq + t, rr2 = dir ? 31 - rr : rr; rbo[t] = (unsigned)rr2 * 20480u + (unsigned)dch * 2u; }
#define HG_ROWBASE(c_) (((c_) < 8) ? (ML + b * CTXL + (dir ? (CTXL - 32 - 32 * (c_)) : 32 * (c_))) : (b * SEQ + (dir ? (63 - ((c_) - 8)) : ((c_) - 8))))
#define HG_LOAD_RAW(c_) do { const char* qb_ = (const char*)(QF + (size_t)HG_ROWBASE(c_) * 10240 + h * 128); const char* zb_ = qb_ + (1 + dir) * 4096; const char* vb_ = qb_ + 12288; \
            _Pragma("unroll") for (int t = 0; t < 8; ++t) { rq[t] = *(const bf16_t*)(qb_ + rbo[t]); rz[t] = *(const bf16_t*)(zb_ + rbo[t]); rv[t] = *(const bf16_t*)(vb_ + rbo[t]); } } while (0)
#define HG_PREP(BO) do { LAS unsigned char* buf_ = lds + (BO); LAS bf16_t* sQ = (LAS bf16_t*)buf_; LAS bf16_t* sK = (LAS bf16_t*)(buf_ + 8704); LAS bf16_t* sKh = (LAS bf16_t*)(buf_ + 17408); \
            LAS bf16_t* sVT = (LAS bf16_t*)(buf_ + 27648); LAS float* sDec = (LAS float*)(buf_ + 37888); \
            float bl[8], kk[8]; float run = 0.f; \
            _Pragma("unroll") for (int t = 0; t < 8; ++t) { const float f = lb + (1.0f - lb) * sigm(bf2f(rz[t])); kk[t] = 1.0f - f; run += __builtin_amdgcn_logf(f); bl[t] = run; } \
            const float t0 = __shfl(run, fr), t1 = __shfl(run, fr + 16), t2 = __shfl(run, fr + 32), t3 = __shfl(run, fr + 48); \
            const float off = (fq > 0 ? t0 : 0.f) + (fq > 1 ? t1 : 0.f) + (fq > 2 ? t2 : 0.f), blast = (t0 + t1) + (t2 + t3); \
            float kh[8]; const float dlast = fexp2(blast); \
            _Pragma("unroll") for (int t = 0; t < 8; ++t) { const float bt = bl[t] + off; const float eb = fexp2(bt), ieb = frcp(eb); const float qt = bf2f(rq[t]) * 0.08838834764831845f * eb, kt = kk[t] * ieb; kh[t] = kt * dlast; \
                sQ[(8 * fq + t) * 136 + dch] = f2bf(qt); sK[(8 * fq + t) * 136 + dch] = f2bf(kt); } \
            u32x4 w; w.x = cvt_pk_bf16(kh[0], kh[1]); w.y = cvt_pk_bf16(kh[2], kh[3]); w.z = cvt_pk_bf16(kh[4], kh[5]); w.w = cvt_pk_bf16(kh[6], kh[7]); \
            *(LAS u32x4*)(sKh + dch * 40 + 8 * fq) = w; \
            u32x4 vw; vw.x = rv[0] | (rv[1] << 16); vw.y = rv[2] | (rv[3] << 16); vw.z = rv[4] | (rv[5] << 16); vw.w = rv[6] | (rv[7] << 16); \
            *(LAS u32x4*)(sVT + dch * 40 + 8 * fq) = vw; \
            if (fq == 0) sDec[dch] = dlast; } while (0)
#define HG_OUT(BO, c_) do { LAS unsigned char* buf_ = lds + (BO); LAS bf16_t* sQ = (LAS bf16_t*)buf_; LAS bf16_t* sK = (LAS bf16_t*)(buf_ + 8704); LAS bf16_t* sVT = (LAS bf16_t*)(buf_ + 27648); \
            f32x4 T00 = (f32x4){0.f, 0.f, 0.f, 0.f}, T01 = T00, T11 = T00; \
            _Pragma("unroll") for (int kk = 0; kk < 4; ++kk) { \
                const bf16x8 ak0 = *(const LAS bf16x8*)(sK + fr * 136 + 32 * kk + 8 * fq), ak1 = *(const LAS bf16x8*)(sK + (16 + fr) * 136 + 32 * kk + 8 * fq); \
                const bf16x8 bq0 = *(const LAS bf16x8*)(sQ + fr * 136 + 32 * kk + 8 * fq), bq1 = *(const LAS bf16x8*)(sQ + (16 + fr) * 136 + 32 * kk + 8 * fq); \
                T00 = __builtin_amdgcn_mfma_f32_16x16x32_bf16(ak0, bq0, T00, 0, 0, 0); \
                T01 = __builtin_amdgcn_mfma_f32_16x16x32_bf16(ak0, bq1, T01, 0, 0, 0); \
                T11 = __builtin_amdgcn_mfma_f32_16x16x32_bf16(ak1, bq1, T11, 0, 0, 0); } \
            _Pragma("unroll") for (int i = 0; i < 4; ++i) if (4 * fq + i > fr) { T00[i] = 0.f; T11[i] = 0.f; } \
            u32x4 P0, P1; \
            P0.x = cvt_pk_bf16(T00[0], T00[1]); P0.y = cvt_pk_bf16(T00[2], T00[3]); P0.z = 0u; P0.w = 0u; \
            P1.x = cvt_pk_bf16(T01[0], T01[1]); P1.y = cvt_pk_bf16(T01[2], T01[3]); P1.z = cvt_pk_bf16(T11[0], T11[1]); P1.w = cvt_pk_bf16(T11[2], T11[3]); \
            f32x4 O0 = (f32x4){0.f, 0.f, 0.f, 0.f}, O1 = O0; \
            { const u32x2 vlo = *(const LAS u32x2*)(sVT + dch * 40 + 4 * fq), vhi = *(const LAS u32x2*)(sVT + dch * 40 + 16 + 4 * fq); \
              u32x4 av; av.x = vlo.x; av.y = vlo.y; av.z = vhi.x; av.w = vhi.y; \
              O0 = __builtin_amdgcn_mfma_f32_16x16x32_bf16(as_bf16x8(av), as_bf16x8(P0), O0, 0, 0, 0); \
              O1 = __builtin_amdgcn_mfma_f32_16x16x32_bf16(as_bf16x8(av), as_bf16x8(P1), O1, 0, 0, 0); } \
            _Pragma("unroll") for (int kk = 0; kk < 4; ++kk) { \
                u32x4 as; as.x = cvt_pk_bf16(S[2 * kk][0], S[2 * kk][1]); as.y = cvt_pk_bf16(S[2 * kk][2], S[2 * kk][3]); \
                as.z = cvt_pk_bf16(S[2 * kk + 1][0], S[2 * kk + 1][1]); as.w = cvt_pk_bf16(S[2 * kk + 1][2], S[2 * kk + 1][3]); \
                const u32x2 q0l = *(const LAS u32x2*)(sQ + fr * 136 + 32 * kk + 4 * fq), q0h = *(const LAS u32x2*)(sQ + fr * 136 + 32 * kk + 16 + 4 * fq); \
                const u32x2 q1l = *(const LAS u32x2*)(sQ + (16 + fr) * 136 + 32 * kk + 4 * fq), q1h = *(const LAS u32x2*)(sQ + (16 + fr) * 136 + 32 * kk + 16 + 4 * fq); \
                u32x4 b0; b0.x = q0l.x; b0.y = q0l.y; b0.z = q0h.x; b0.w = q0h.y; \
                u32x4 b1; b1.x = q1l.x; b1.y = q1l.y; b1.z = q1h.x; b1.w = q1h.y; \
                O0 = __builtin_amdgcn_mfma_f32_16x16x32_bf16(as_bf16x8(as), as_bf16x8(b0), O0, 0, 0, 0); \
                O1 = __builtin_amdgcn_mfma_f32_16x16x32_bf16(as_bf16x8(as), as_bf16x8(b1), O1, 0, 0, 0); } \
            { const int rb_ = HG_ROWBASE(c_); const int row0 = rb_ + (dir ? 31 - fr : fr) * 64, row1 = rb_ + (dir ? 15 - fr : 16 + fr) * 64; \
              u32x2 w0; w0.x = cvt_pk_bf16(O0[0], O0[1]); w0.y = cvt_pk_bf16(O0[2], O0[3]); \
              u32x2 w1; w1.x = cvt_pk_bf16(O1[0], O1[1]); w1.y = cvt_pk_bf16(O1[2], O1[3]); \
              *(u32x2*)(OO + (size_t)row0 * 2048 + h * 128 + 16 * wid + 4 * fq) = w0; \
              *(u32x2*)(OO + (size_t)row1 * 2048 + h * 128 + 16 * wid + 4 * fq) = w1; } } while (0)
#define HG_UPD(BO) do { LAS unsigned char* buf_ = lds + (BO); LAS bf16_t* sKh = (LAS bf16_t*)(buf_ + 17408); LAS bf16_t* sVT = (LAS bf16_t*)(buf_ + 27648); LAS float* sDec = (LAS float*)(buf_ + 37888); \
            const bf16x8 bv = *(const LAS bf16x8*)(sVT + dch * 40 + 8 * fq); \
            _Pragma("unroll") for (int T = 0; T < 8; ++T) { \
                const f32x4 dec = *(const LAS f32x4*)(sDec + 16 * T + 4 * fq); \
                const bf16x8 akh = *(const LAS bf16x8*)(sKh + (16 * T + fr) * 40 + 8 * fq); \
                S[T] = __builtin_amdgcn_mfma_f32_16x16x32_bf16(akh, bv, S[T] * dec, 0, 0, 0); } } while (0)
        HG_LOAD_RAW(0); HG_PREP(0); HG_LOAD_RAW(1);
        for (int c = 0; c < 8; c += 2) {
            LDS_BARRIER(); HG_UPD(0); HG_PREP(BUFB);
            if (c + 2 == 8) {
#pragma unroll
                for (int t = 0; t < 8; ++t) { const int rr = 8 * fq + t, rr2 = dir ? 31 - rr : rr; rbo[t] = (unsigned)rr2 * (64u * 20480u) + (unsigned)dch * 2u; }
            }
            HG_LOAD_RAW(c + 2);
            LDS_BARRIER(); HG_UPD(BUFB); HG_PREP(0); HG_LOAD_RAW(c + 3);
        }
        for (int c = 8; c < 72; c += 2) {
            LDS_BARRIER(); HG_OUT(0, c); HG_UPD(0); HG_PREP(BUFB);
            if (c + 2 < 72) HG_LOAD_RAW(c + 2);
            LDS_BARRIER(); HG_OUT(BUFB, c + 1); HG_UPD(BUFB);
            if (c + 2 < 72) { HG_PREP(0); if (c + 3 < 72) HG_LOAD_RAW(c + 3); }
        }
        __syncthreads();
    }
}
__device__ __forceinline__ void hg_combine_phase(const Params& p) {
    const int tid = opaque_tid(); const int lane = tid & 63, wave = blockIdx.x * 8 + (tid >> 6), nw = gridDim.x * 8;
    bf16_t* OF = (bf16_t*)(p.ws + OFF_A0); const bf16_t* OB = (const bf16_t*)(p.ws + OFF_HB); const bf16_t* QF = (const bf16_t*)(p.ws + OFF_BIG);
    const int e4 = (lane & 31) * 4;
    const f32x4 nw4 = *(const f32x4*)(p.in[I_HGNORM] + e4);
    for (int pr0 = wave; pr0 < ML * 8; pr0 += nw * 8) {
        u32x2 a[8], bq[8], gq[8];
#pragma unroll
        for (int k = 0; k < 8; ++k) { const int pr = pr0 + k * nw; if (pr < ML * 8) { const int r = pr >> 3, col = ((pr & 7) * 2 + (lane >> 5)) * 128 + e4;
            a[k] = __builtin_nontemporal_load((const u32x2*)(OF + (size_t)r * 2048 + col)); bq[k] = __builtin_nontemporal_load((const u32x2*)(OB + (size_t)r * 2048 + col)); gq[k] = __builtin_nontemporal_load((const u32x2*)(QF + (size_t)r * 10240 + 4 * 2048 + col)); } }
#pragma unroll
        for (int k = 0; k < 8; ++k) { const int pr = pr0 + k * nw; if (pr < ML * 8) { const int r = pr >> 3, col = ((pr & 7) * 2 + (lane >> 5)) * 128 + e4;
            float o[4] = {bflo(a[k].x) + bflo(bq[k].x), bfhi(a[k].x) + bfhi(bq[k].x), bflo(a[k].y) + bflo(bq[k].y), bfhi(a[k].y) + bfhi(bq[k].y)};
            float ss = o[0] * o[0] + o[1] * o[1] + o[2] * o[2] + o[3] * o[3];
#pragma unroll
            for (int off = 16; off >= 1; off >>= 1) ss += __shfl_xor(ss, off);
            const float rstd = rsqrtf(ss * (1.0f / 128.0f) + 1e-6f);
            const float g[4] = {bflo(gq[k].x), bfhi(gq[k].x), bflo(gq[k].y), bfhi(gq[k].y)};
            float y[4];
#pragma unroll
            for (int j = 0; j < 4; ++j) y[j] = o[j] * rstd * nw4[j] * silu_f(g[j]);
            u32x2 w; w.x = cvt_pk_bf16(y[0], y[1]); w.y = cvt_pk_bf16(y[2], y[3]);
            *(u32x2*)(OF + (size_t)r * 2048 + col) = w; } }
    }
}

#define XB_TMO      128
#define XB_XCNT(j)  (256  + 64 * (j))
#define XB_XSUB(j)  (1280 + 64 * (j))
#define XB_XGEN(j)  (2304 + 64 * (j))
#define XB_TOP      3328
#define XB_TOPGEN   3392
#define XCD_BAR_WORDS 3456
#define XB_SPIN_CAP (1u << 18)

__device__ __forceinline__ unsigned xb_ld(unsigned* p)              { return __hip_atomic_load(p, __ATOMIC_RELAXED, __HIP_MEMORY_SCOPE_AGENT); }
__device__ __forceinline__ unsigned xb_add(unsigned* p, unsigned v) { return __hip_atomic_fetch_add(p, v, __ATOMIC_RELAXED, __HIP_MEMORY_SCOPE_AGENT); }
__device__ __forceinline__ unsigned xb_xcc_id() { return (unsigned)__builtin_amdgcn_s_getreg((3 << 11) | 20) & 0xFu; }
#define XB_SPIN(cond, bar) do { unsigned _sp = 0; while (cond) { __builtin_amdgcn_s_sleep(1); \
    if ((++_sp & 255u) == 0u) { if (xb_ld(&(bar)[XB_TMO])) break; if (_sp > XB_SPIN_CAP) { atomicAdd(&(bar)[XB_TMO], 1u); break; } } } } while (0)

struct XcdBarrier {
    unsigned* bar; unsigned x;
    volatile LAS unsigned* st;
};

__device__ __forceinline__ XcdBarrier xcd_barrier_post(unsigned* bar, volatile LAS unsigned* st) {
    XcdBarrier b; b.bar = bar; b.x = xb_xcc_id(); b.st = st;
    if (threadIdx.x == 0) (void)xb_add(&bar[XB_XCNT(b.x)], 1u);
    return b;
}
__device__ __forceinline__ void xcd_barrier_complete(unsigned* bar, unsigned x, unsigned& nloc, unsigned& nx) {
    const unsigned G = gridDim.x * gridDim.y * gridDim.z;
    unsigned sum, cnt, mine, sp = 0u;
    for (;;) {
        sum = 0u; cnt = 0u; mine = 0u;
#pragma unroll
        for (unsigned j = 0; j < 16; ++j) { const unsigned c = xb_ld(&bar[XB_XCNT(j)]); sum += c; cnt += (c > 0u) ? 1u : 0u; mine = (j == x) ? c : mine; }
        if (sum == G) break;
        __builtin_amdgcn_s_sleep(1);
        if ((++sp & 255u) == 0u) { if (xb_ld(&bar[XB_TMO])) break; if (sp > XB_SPIN_CAP) { atomicAdd(&bar[XB_TMO], 1u); break; } }
    }
    nloc = mine > 0u ? mine : 1u; nx = cnt > 0u ? cnt : 1u;
}

__device__ __forceinline__ void xcd_barrier(const XcdBarrier& b) {
    asm volatile("s_waitcnt vmcnt(0)" ::: "memory");
    __syncthreads();
    if (threadIdx.x == 0) {
        unsigned* bar = b.bar;
        __builtin_amdgcn_s_waitcnt(0);
        unsigned nloc = b.st[0], nx = b.st[1];
        if (nloc == 0u) { xcd_barrier_complete(bar, b.x, nloc, nx); b.st[0] = nloc; b.st[1] = nx; }
        const unsigned old = xb_add(&bar[XB_XSUB(b.x)], 1u);
        const unsigned gen = old / nloc;
        if (old + 1u == (gen + 1u) * nloc) {
            __builtin_amdgcn_fence(__ATOMIC_RELEASE, "agent");
            asm volatile("s_waitcnt vmcnt(0)" ::: "memory");
            const unsigned og = xb_add(&bar[XB_TOP], 1u);
            const unsigned tg = og / nx;
            if (og + 1u == (tg + 1u) * nx) xb_add(&bar[XB_TOPGEN], 1u);
            else XB_SPIN(xb_ld(&bar[XB_TOPGEN]) == tg, bar);
            __builtin_amdgcn_fence(__ATOMIC_ACQUIRE, "agent");
            xb_add(&bar[XB_XGEN(b.x)], 1u);
            asm volatile("s_waitcnt vmcnt(0)" ::: "memory");
        } else {
            XB_SPIN(xb_ld(&bar[XB_XGEN(b.x)]) == gen, bar);
            __builtin_amdgcn_fence(__ATOMIC_ACQUIRE, "agent");
            asm volatile("s_waitcnt vmcnt(0)" ::: "memory");
        }
    }
    __syncthreads();
}


__global__ __launch_bounds__(512, 2) void mk_fwd(Params p) {
    extern __shared__ __attribute__((aligned(16))) unsigned char shm[];
    LAS unsigned char* lds = (LAS unsigned char*)shm;
    cg::grid_group grid = cg::this_grid();
    const float* mod = (const float*)(p.ws + OFF_MOD);
    const bf16_t* A0 = (const bf16_t*)(p.ws + OFF_A0);
    bf16_t* BIG = (bf16_t*)(p.ws + OFF_BIG);
    float* XC = (float*)(p.ws + OFF_XC);

    volatile LAS unsigned* xst = (volatile LAS unsigned*)(lds + LDS_BYTES - 16);
    if (threadIdx.x == 0) { xst[0] = 0u; xst[1] = 0u; }
    __syncthreads();
    const XcdBarrier xb = xcd_barrier_post((unsigned*)(p.ws + OFF_BAR), xst);
    if (gridDim.x > 65535u * 64u) grid.sync();
    prep_phase(p, lds); xcd_barrier(xb);
    mod_phase(p, 0, 0, MT, 0); xcd_barrier(xb);
    { EpiBf16 E; E.O = BIG; E.ldc = 4096; run_gemm(lds, A0, (const bf16_t*)(p.ws + OFF_WRGIN), MT, 4096, 2048, E); } xcd_barrier(xb);
    rg_scan_phase(p, lds); xcd_barrier(xb);
    rg_combine_phase(p); xcd_barrier(xb);
    { EpiResid E; E.in_lat = p.in[I_X]; E.in_ctx = p.in[I_CTX]; E.out_lat = p.out; E.out_ctx = XC; E.gate = mod + 2 * 2048;
      if (gridDim.x >= 256) { run_gemm(lds, A0, (const bf16_t*)(p.ws + OFF_WRGOUT), ML, 2048, 2048, E); splitk_ctx_gemm(lds, p, A0, (const bf16_t*)(p.ws + OFF_WRGOUT), 2048); }
      else run_gemm(lds, A0, (const bf16_t*)(p.ws + OFF_WRGOUT), MT, 2048, 2048, E); }
    xcd_barrier(xb);
    { const float* part = gridDim.x >= 256 ? (const float*)(p.ws + OFF_PART) : nullptr; mod_phase(p, 0, 1, MT, 1, part, p.in[I_CTX], mod + (size_t)8 * 12288 + 2 * 2048); } xcd_barrier(xb);
    { EpiSwiglu E; E.O = BIG; E.ldc = FF; run_gemm(lds, A0, (const bf16_t*)(p.ws + OFF_WFFNIN0), MT, 2 * FF, 2048, E); } xcd_barrier(xb);
    { EpiResid E; E.in_lat = p.out; E.in_ctx = XC; E.out_lat = p.out; E.out_ctx = XC; E.gate = mod + 5 * 2048;
      if (gridDim.x >= 256) { run_gemm(lds, BIG, (const bf16_t*)(p.ws + OFF_WFFNOUT0), ML, 2048, FF, E); splitk_ctx_gemm(lds, p, BIG, (const bf16_t*)(p.ws + OFF_WFFNOUT0), FF); }
      else run_gemm(lds, BIG, (const bf16_t*)(p.ws + OFF_WFFNOUT0), MT, 2048, FF, E); }
    xcd_barrier(xb);
    { const float* part = gridDim.x >= 256 ? (const float*)(p.ws + OFF_PART) : nullptr; mod_phase(p, 1, 0, MT, 1, part, XC, mod + (size_t)8 * 12288 + 5 * 2048); } xcd_barrier(xb);
    { EpiBf16 E; E.O = BIG; E.ldc = 10240; pg8::Gemm g; g.A = A0; g.Bt = (const bf16_t*)(p.ws + OFF_WHGIN); g.M = MT; g.N = 10240; g.K = 2048; g.ld = 2048;
      SchedHgIn S; S.init((int)gridDim.x, (int)blockIdx.x); pg8::gemm_phase<EpiBf16, SchedHgIn, GEMM_ALIGN, GEMM_SP2>(lds, g, S, E); } xcd_barrier(xb);
    hg_scan_mfma(p, lds); xcd_barrier(xb);
    hg_combine_phase(p); xcd_barrier(xb);
    { EpiResid E; E.in_lat = p.out; E.in_ctx = XC; E.out_lat = p.out; E.out_ctx = XC; E.gate = mod + (size_t)9 * 12288 + 2 * 2048;
      run_gemm(lds, A0, (const bf16_t*)(p.ws + OFF_WHGOUT), ML, 2048, 2048, E); } xcd_barrier(xb);
    mod_phase(p, 1, 1, ML, 1); xcd_barrier(xb);
    { EpiSwiglu E; E.O = BIG; E.ldc = FF; run_gemm(lds, A0, (const bf16_t*)(p.ws + OFF_WFFNIN1), ML, 2 * FF, 2048, E); } xcd_barrier(xb);
    { EpiResid E; E.in_lat = p.out; E.in_ctx = XC; E.out_lat = p.out; E.out_ctx = XC; E.gate = mod + (size_t)9 * 12288 + 5 * 2048;
      run_gemm(lds, BIG, (const bf16_t*)(p.ws + OFF_WFFNOUT1), ML, 2048, FF, E); } xcd_barrier(xb);
    final_phase(p);
}

extern "C" void kernel_launch(void* const* d_in, const int* in_sizes, int n_in, void* d_out, int out_size, void* d_ws, size_t ws_size, hipStream_t stream) {
    static int grid = 0;
    if (grid == 0) {
        if (n_in != 24 || ws_size < WS_END) { fprintf(stderr, "kernel_launch: n_in %d ws %zu (need %zu)\n", n_in, ws_size, (size_t)WS_END); grid = -1; return; }
        int dev = 0, cus = 0, per_cu = 0;
        (void)hipGetDevice(&dev);
        (void)hipDeviceGetAttribute(&cus, hipDeviceAttributeMultiprocessorCount, dev);
        if (hipFuncSetAttribute((const void*)mk_fwd, hipFuncAttributeMaxDynamicSharedMemorySize, LDS_BYTES) != hipSuccess) fprintf(stderr, "kernel_launch: hipFuncSetAttribute failed\n");
        if (hipOccupancyMaxActiveBlocksPerMultiprocessor(&per_cu, (const void*)mk_fwd, 512, LDS_BYTES) != hipSuccess || per_cu < 1) { fprintf(stderr, "kernel_launch: occupancy query says %d\n", per_cu); per_cu = 1; }
        (void)hipGetLastError();
        grid = cus * per_cu;
    }
    if (grid < 0) return;
    Params p{};
    for (int i = 0; i < 24; ++i) p.in[i] = (const float*)d_in[i];
    p.out = (float*)d_out; p.ws = (unsigned char*)d_ws;
    (void)hipMemsetAsync((unsigned char*)d_ws + OFF_BAR, 0, XCD_BAR_WORDS * sizeof(unsigned), stream);
    void* args[] = {&p};
    const hipError_t e = hipLaunchCooperativeKernel((void*)mk_fwd, dim3(grid), dim3(512), args, LDS_BYTES, stream);
    if (e != hipSuccess) fprintf(stderr, "kernel_launch: cooperative launch failed: %s (grid %d)\n", hipGetErrorString(e), grid);
}
```

```cpp
#include <hip/hip_runtime.h>
#include <hip/hip_cooperative_groups.h>
#include <cstdio>
namespace cg = cooperative_groups;
namespace pg8 {
#define PG8_LAS __attribute__((address_space(3)))
typedef unsigned short bf16_t;
typedef short bf16x8 __attribute__((ext_vector_type(8)));
typedef float f32x4 __attribute__((ext_vector_type(4)));
typedef unsigned u32x4 __attribute__((ext_vector_type(4)));
constexpr int BM = 256, BK = 64, HALF = 128, HTB = HALF * BK * 2  , STAGE_BYTES = 8 * HTB, NXCD = 8, WGM = 4;

__host__ __device__ __forceinline__ int lds_byte(int r, int c) { const int st = (r >> 4) * 2 + (c >> 5), rr = r & 15, cc = c & 31, ob = rr * 64 + cc * 2; return st * 1024 + (ob ^ (((ob >> 9) & 1) << 5)); }
__host__ __device__ __forceinline__ void stage_rc(int b, int& R, int& C) { const int st = b / 1024, sb = b % 1024, swz = sb ^ (((sb >> 9) & 1) << 5); R = (st >> 1) * 16 + swz / 64; C = (st & 1) * 32 + (swz % 64) / 2; }
__host__ __device__ __forceinline__ int perm32(int rho) { const int n = rho >> 4, i = rho & 15; return 8 * (i >> 2) + 4 * n + (i & 3); }

struct Unit { int pm, pn; };
struct Gemm { const bf16_t* A; const bf16_t* Bt; int M, N, K, ld; };

struct StaticOrder {
    int nM, nN, nwg, G, c;
    __host__ __device__ void init(int M, int N, int G_, int c_) { nM = M / BM; nN = N / BM; nwg = nM * nN; G = G_; c = c_; }
    __host__ __device__ bool next(int i, Unit& u) const {
        const long L = (long)i * G + c; if (L >= nwg) return false;
        int wgid = (int)L; { const int q = nwg / NXCD, r = nwg % NXCD, xcd = wgid % NXCD, off = wgid / NXCD; wgid = (xcd < r ? xcd * (q + 1) : r * (q + 1) + (xcd - r) * q) + off; }
        const int nig = WGM * nN, gid = wgid / nig, fm = gid * WGM, gsz = (nM - fm) < WGM ? (nM - fm) : WGM;
        u.pm = fm + ((wgid % nig) % gsz); u.pn = (wgid % nig) / gsz; return true;
    }
    __device__ __forceinline__ void a_ready(const Unit&) const {}
    __device__ __forceinline__ void done(const Unit&) const {}
};
typedef __bf16 bf16v2_t __attribute__((ext_vector_type(2)));
typedef float f32x2v_t __attribute__((ext_vector_type(2)));
__device__ __forceinline__ unsigned cvt_pk_bf16(float lo, float hi) { const f32x2v_t v = {lo, hi}; const bf16v2_t r = __builtin_convertvector(v, bf16v2_t); return __builtin_bit_cast(unsigned, r); }
template <class Epi, class Sched, bool ALIGN_EPI = false, bool SP2 = false>
__device__ __forceinline__ void gemm_phase(PG8_LAS unsigned char* lds, const Gemm g, const Sched& S, const Epi& E) {
    int tid_ = threadIdx.x; asm volatile("" : "+v"(tid_)); const int tid = tid_, wid = __builtin_amdgcn_readfirstlane(tid >> 6), lane = tid & 63, wr = wid >> 2, wc = wid & 3, fr = lane & 15, fq = lane >> 4;
    const int K = g.ld, nt = g.K / BK;
    unsigned voffA[2], voffB[2];
#pragma unroll
    for (int i = 0; i < 2; ++i) { int R, C; stage_rc(tid * 16 + i * 8192, R, C); const int Rb = Epi::PERM ? ((R & ~31) + perm32(R & 31)) : R;
        voffA[i] = (unsigned)(R * K + C) * 2u; voffB[i] = (unsigned)(Rb * K + C) * 2u; }
    const size_t kstep = (size_t)(BK * 2);
    const size_t hstep = (size_t)HALF * K * 2;
    const size_t tstep = 2 * hstep;
    const unsigned ldsw = (unsigned)wid * 1024u;
    const int aoff = lds_byte(wr * 64 + fr, fq * 8), boff = lds_byte(wc * 32 + fr, fq * 8);
#define PG8_SA(b, h) (((b) * 2 + (h)) * HTB)
#define PG8_SB(b, h) ((4 + (b) * 2 + (h)) * HTB)
#define PG8_STAGE(bufoff, gbase, voff) do { _Pragma("unroll") for (int _i = 0; _i < 2; ++_i) \
        __builtin_amdgcn_global_load_lds((const unsigned*)((const char*)(gbase) + (voff)[_i]), (PG8_LAS unsigned*)(lds + (bufoff) + ldsw + _i * 8192), 16, 0, 0); } while (0)
#define PG8_LDA(dst, b, h) do { _Pragma("unroll") for (int m = 0; m < 4; ++m) _Pragma("unroll") for (int k = 0; k < 2; ++k) dst[m][k] = *(const PG8_LAS bf16x8*)(lds + PG8_SA(b, h) + aoff + m * 2048 + k * 1024); } while (0)
#define PG8_LDB(dst, b, h) do { _Pragma("unroll") for (int n = 0; n < 2; ++n) _Pragma("unroll") for (int k = 0; k < 2; ++k) dst[n][k] = *(const PG8_LAS bf16x8*)(lds + PG8_SB(b, h) + boff + n * 2048 + k * 1024); } while (0)
#define PG8_MMA(ai, bj, At, Bt) do { __builtin_amdgcn_s_setprio(1); _Pragma("unroll") for (int m = 0; m < 4; ++m) _Pragma("unroll") for (int n = 0; n < 2; ++n) _Pragma("unroll") for (int k = 0; k < 2; ++k) \
        acc[ai][bj][m][n] = __builtin_amdgcn_mfma_f32_16x16x32_bf16(Bt[n][k], At[m][k], acc[ai][bj][m][n], 0, 0, 0); __builtin_amdgcn_s_setprio(0); } while (0)
#define PG8_WAIT_V(n) asm volatile("s_waitcnt vmcnt(" #n ")" ::: "memory")
#define PG8_WAIT_L(n) asm volatile("s_waitcnt lgkmcnt(" #n ")" ::: "memory")
#define PG8_BAR __builtin_amdgcn_s_barrier()
#define PG8_SCHED __builtin_amdgcn_sched_barrier(0)
    Unit cur, nxt; int ui = 0;
    if (!S.next(0, cur)) return;
    f32x4 acc[2][2][4][2];
#pragma unroll
    for (int a = 0; a < 2; ++a)
#pragma unroll
        for (int b = 0; b < 2; ++b)
#pragma unroll
            for (int m = 0; m < 4; ++m)
#pragma unroll
                for (int n = 0; n < 2; ++n) acc[a][b][m][n] = (f32x4){0.f, 0.f, 0.f, 0.f};
    bf16x8 At[4][2], B0[2][2], B1[2][2];
    const char* cA = (const char*)g.A + (size_t)cur.pm * tstep; const char* cB = (const char*)g.Bt + (size_t)cur.pn * tstep;
    S.a_ready(cur);
    if constexpr (SP2) {
        PG8_STAGE(PG8_SB(0, 0), cB, voffB); PG8_STAGE(PG8_SB(0, 1), cB + hstep, voffB); PG8_STAGE(PG8_SA(0, 0), cA, voffA); PG8_STAGE(PG8_SA(0, 1), cA + hstep, voffA);
        if (wr == 1) PG8_BAR;
        PG8_WAIT_V(2); PG8_BAR;
        PG8_STAGE(PG8_SB(1, 0), cB + kstep, voffB); PG8_STAGE(PG8_SA(1, 0), cA + kstep, voffA); PG8_STAGE(PG8_SB(1, 1), cB + hstep + kstep, voffB);
        PG8_WAIT_V(6); PG8_BAR;
    } else {
        PG8_STAGE(PG8_SB(0, 0), cB, voffB); PG8_STAGE(PG8_SA(0, 0), cA, voffA); PG8_STAGE(PG8_SB(0, 1), cB + hstep, voffB); PG8_STAGE(PG8_SA(0, 1), cA + hstep, voffA);
        if (wr == 1) PG8_BAR;
        PG8_WAIT_V(4); PG8_BAR;
        PG8_STAGE(PG8_SB(1, 0), cB + kstep, voffB); PG8_STAGE(PG8_SA(1, 0), cA + kstep, voffA); PG8_STAGE(PG8_SB(1, 1), cB + hstep + kstep, voffB);
        PG8_WAIT_V(6); PG8_BAR;
    }
    for (;;) {
        const bool has_next = S.next(ui + 1, nxt);
        const char* nA = has_next ? (const char*)g.A + (size_t)nxt.pm * tstep : cA; const char* nB = has_next ? (const char*)g.Bt + (size_t)nxt.pn * tstep : cB;
        for (int t = 0; t < nt; t += 2) {
            const bool last = (t == nt - 2);
            const char* a1 = cA + (size_t)(t + 1) * kstep;
            const char* a2 = last ? nA : cA + (size_t)(t + 2) * kstep; const char* b2 = last ? nB : cB + (size_t)(t + 2) * kstep;
            const char* a3 = a2 + kstep; const char* b3 = b2 + kstep;
            if (last && has_next) S.a_ready(nxt);
            if constexpr (SP2) {
            PG8_LDB(B0, 0, 0); PG8_LDB(B1, 0, 1); PG8_SCHED; PG8_LDA(At, 0, 0); PG8_STAGE(PG8_SA(1, 1), a1 + hstep, voffA);
            PG8_WAIT_V(8); PG8_WAIT_L(0); PG8_BAR; PG8_MMA(0, 0, At, B0); PG8_MMA(0, 1, At, B1); PG8_BAR; PG8_SCHED;
            PG8_LDA(At, 0, 1); PG8_STAGE(PG8_SB(0, 0), b2, voffB); PG8_STAGE(PG8_SB(0, 1), b2 + hstep, voffB); PG8_STAGE(PG8_SA(0, 0), a2, voffA);
            PG8_WAIT_V(8); PG8_WAIT_L(0); PG8_BAR; PG8_MMA(1, 0, At, B0); PG8_MMA(1, 1, At, B1); PG8_BAR; PG8_SCHED;
            PG8_LDB(B0, 1, 0); PG8_LDB(B1, 1, 1); PG8_SCHED; PG8_LDA(At, 1, 0); PG8_STAGE(PG8_SA(0, 1), a2 + hstep, voffA);
            PG8_WAIT_V(8); PG8_WAIT_L(0); PG8_BAR; PG8_MMA(0, 0, At, B0); PG8_MMA(0, 1, At, B1); PG8_BAR; PG8_SCHED;
            PG8_LDA(At, 1, 1); PG8_STAGE(PG8_SB(1, 0), b3, voffB); PG8_STAGE(PG8_SB(1, 1), b3 + hstep, voffB); PG8_STAGE(PG8_SA(1, 0), a3, voffA);
            PG8_WAIT_V(8); PG8_WAIT_L(0); PG8_BAR; PG8_MMA(1, 0, At, B0); PG8_MMA(1, 1, At, B1); PG8_BAR; PG8_SCHED;
            } else {
            PG8_LDB(B0, 0, 0); PG8_SCHED; PG8_LDA(At, 0, 0); PG8_STAGE(PG8_SA(1, 1), a1 + hstep, voffA);
            PG8_WAIT_L(8); PG8_BAR; PG8_WAIT_L(0); PG8_MMA(0, 0, At, B0); PG8_BAR; PG8_SCHED;
            PG8_LDB(B1, 0, 1); PG8_STAGE(PG8_SB(0, 0), b2, voffB);
            PG8_BAR; PG8_WAIT_L(0); PG8_MMA(0, 1, At, B1); PG8_BAR;
            PG8_LDA(At, 0, 1); PG8_STAGE(PG8_SA(0, 0), a2, voffA);
            PG8_BAR; PG8_WAIT_L(0); PG8_MMA(1, 0, At, B0); PG8_BAR; PG8_SCHED;
            PG8_STAGE(PG8_SB(0, 1), b2 + hstep, voffB);
            PG8_WAIT_V(6); PG8_BAR; PG8_MMA(1, 1, At, B1); PG8_BAR;
            PG8_LDB(B0, 1, 0); PG8_SCHED; PG8_LDA(At, 1, 0); PG8_STAGE(PG8_SA(0, 1), a2 + hstep, voffA);
            PG8_WAIT_L(8); PG8_BAR; PG8_WAIT_L(0); PG8_MMA(0, 0, At, B0); PG8_BAR; PG8_SCHED;
            PG8_LDB(B1, 1, 1); PG8_STAGE(PG8_SB(1, 0), b3, voffB);
            PG8_BAR; PG8_WAIT_L(0); PG8_MMA(0, 1, At, B1); PG8_BAR;
            PG8_LDA(At, 1, 1); PG8_STAGE(PG8_SA(1, 0), a3, voffA);
            PG8_BAR; PG8_WAIT_L(0); PG8_MMA(1, 0, At, B0); PG8_BAR; PG8_SCHED;
            PG8_STAGE(PG8_SB(1, 1), b3 + hstep, voffB);
            PG8_WAIT_V(6); PG8_BAR; PG8_MMA(1, 1, At, B1); PG8_BAR;
            }
        }
        if constexpr (ALIGN_EPI) { if (wr == 0) PG8_BAR; }
        if constexpr (!Epi::AFTER_DRAIN) { E(acc, cur, wr, wc, fr, fq); S.done(cur); }
        if (!has_next) break;
#pragma unroll
        for (int a = 0; a < 2; ++a)
#pragma unroll
            for (int b = 0; b < 2; ++b)
#pragma unroll
                for (int m = 0; m < 4; ++m)
#pragma unroll
                    for (int n = 0; n < 2; ++n) acc[a][b][m][n] = (f32x4){0.f, 0.f, 0.f, 0.f};
        cur = nxt; cA = nA; cB = nB; ++ui;
        if constexpr (ALIGN_EPI) { if (wr == 1) PG8_BAR; }
    }
    PG8_WAIT_V(0);
    if constexpr (!ALIGN_EPI) { if (wr == 0) PG8_BAR; }
    PG8_BAR;
    if constexpr (Epi::AFTER_DRAIN) { E.fused(acc, cur, wr, wc, fr, fq, lds, wid, lane); S.done(cur); }
#undef PG8_SA
#undef PG8_SB
#undef PG8_STAGE
#undef PG8_LDA
#undef PG8_LDB
#undef PG8_MMA
#undef PG8_WAIT_V
#undef PG8_WAIT_L
#undef PG8_BAR
#undef PG8_SCHED
}
}


using pg8::bf16_t; using pg8::bf16x8; using pg8::f32x4; using pg8::u32x4; using pg8::Unit; using pg8::cvt_pk_bf16;
#define LAS __attribute__((address_space(3)))
typedef unsigned u32x2 __attribute__((ext_vector_type(2)));

constexpr int D = 2048, NB = 8, SEQ = 2048, CTXL = 256, FF = 5632;
constexpr int ML = NB * SEQ, MC = NB * CTXL, MT = ML + MC;
constexpr size_t MiB = 1048576;
constexpr size_t OFF_WRGIN = 0, OFF_WRGOUT = 16 * MiB, OFF_WFFNIN0 = 24 * MiB, OFF_WFFNIN1 = 68 * MiB, OFF_WFFNOUT0 = 112 * MiB, OFF_WFFNOUT1 = 134 * MiB,
                 OFF_WHGIN = 156 * MiB, OFF_WHGOUT = 196 * MiB, OFF_A0 = 204 * MiB, OFF_HB = 276 * MiB, OFF_BIG = 348 * MiB, OFF_XC = 708 * MiB, OFF_MOD = 724 * MiB,
                 OFF_BAR = 724 * MiB + 917504, OFF_PART = OFF_BIG + 208 * MiB  , WS_END = 725 * MiB;
constexpr int LDS_BYTES = 144 * 1024;
constexpr bool GEMM_ALIGN = true, GEMM_SP2 = true;

struct Params { const float* in[24]; float* out; unsigned char* ws; };
enum { I_X = 0, I_C, I_CTX, I_CCTX, I_WADA, I_BADA, I_GMIX, I_GFFN, I_GFINAL, I_WFFNIN, I_WFFNOUT, I_RGWIN, I_RGCONVW, I_RGCONVB, I_RGWA, I_RGBA, I_RGWI, I_RGBI, I_RGLAM,
       I_RGWOUT, I_HGWIN, I_HGLB, I_HGNORM, I_HGWOUT };

__device__ __forceinline__ int opaque_tid() { int t = threadIdx.x; asm volatile("" : "+v"(t)); return t; }
__device__ __forceinline__ float bf2f(unsigned v) { return __uint_as_float(v << 16); }
__device__ __forceinline__ float bflo(unsigned w) { return __uint_as_float(w << 16); }
__device__ __forceinline__ float bfhi(unsigned w) { return __uint_as_float(w & 0xffff0000u); }
__device__ __forceinline__ float frcp(float x) { return __builtin_amdgcn_rcpf(x); }
__device__ __forceinline__ float fexp2(float x) { return __builtin_amdgcn_exp2f(x); }
__device__ __forceinline__ float sigm(float x) { return frcp(1.0f + fexp2(-1.4426950408889634f * x)); }
__device__ __forceinline__ float silu_f(float x) { return x * frcp(1.0f + fexp2(-1.4426950408889634f * x)); }
__device__ __forceinline__ float gelu_tanh_f(float x) { const float u = 0.7978845608028654f * (x + 0.044715f * x * x * x); return x * frcp(1.0f + fexp2(-2.8853900817779268f * u)); }
template <int CTRL> __device__ __forceinline__ float dpp_f(float oldv, float src) { return __int_as_float(__builtin_amdgcn_update_dpp(__float_as_int(oldv), __float_as_int(src), CTRL, 0xf, 0xf, false)); }
__device__ __forceinline__ bf16_t f2bf(float f) { return (bf16_t)(cvt_pk_bf16(f, 0.f) & 0xffffu); }

__device__ __forceinline__ void conv_job(const Params& p, int tile, const float*& W, bf16_t*& Wt, int& K, int& N, int& mode, int& local) {
    bf16_t* ws = (bf16_t*)p.ws;
    if (tile < 1024)       { W = p.in[I_RGWIN]; Wt = (bf16_t*)(p.ws + OFF_WRGIN); K = 2048; N = 4096; mode = 0; local = tile; }
    else if (tile < 1536)  { W = p.in[I_RGWOUT]; Wt = (bf16_t*)(p.ws + OFF_WRGOUT); K = 2048; N = 2048; mode = 0; local = tile - 1024; }
    else if (tile < 4352)  { W = p.in[I_WFFNIN]; Wt = (bf16_t*)(p.ws + OFF_WFFNIN0); K = 2048; N = 11264; mode = 1; local = tile - 1536; }
    else if (tile < 7168)  { W = p.in[I_WFFNIN] + (size_t)2048 * 11264; Wt = (bf16_t*)(p.ws + OFF_WFFNIN1); K = 2048; N = 11264; mode = 1; local = tile - 4352; }
    else if (tile < 8576)  { W = p.in[I_WFFNOUT]; Wt = (bf16_t*)(p.ws + OFF_WFFNOUT0); K = 5632; N = 2048; mode = 0; local = tile - 7168; }
    else if (tile < 9984)  { W = p.in[I_WFFNOUT] + (size_t)5632 * 2048; Wt = (bf16_t*)(p.ws + OFF_WFFNOUT1); K = 5632; N = 2048; mode = 0; local = tile - 8576; }
    else if (tile < 12544) { W = p.in[I_HGWIN]; Wt = (bf16_t*)(p.ws + OFF_WHGIN); K = 2048; N = 10240; mode = 0; local = tile - 9984; }
    else                   { W = p.in[I_HGWOUT]; Wt = (bf16_t*)(p.ws + OFF_WHGOUT); K = 2048; N = 2048; mode = 0; local = tile - 12544; }
    (void)ws;
}
constexpr int N_CONV_TILES = 13056;

__device__ __forceinline__ void convert_range(const Params& p, LAS unsigned char* lds, int first, int last, int w, int nw) {
    const int tid = opaque_tid();
    LAS float* st = (LAS float*)lds;
    const int col4 = tid & 15, krow = tid >> 4;
    const int nn = tid & 63, kg = tid >> 6;
    f32x4 rg[4];
    int tile = first + w;
    if (tile < last) {
        const float* W; bf16_t* Wt; int K, N, mode, local; conv_job(p, tile, W, Wt, K, N, mode, local);
        const int ntn = N >> 6, k0 = (local / ntn) * 128, n0 = (local % ntn) * 64;
#pragma unroll
        for (int ps = 0; ps < 4; ++ps) rg[ps] = __builtin_nontemporal_load((const f32x4*)(W + (size_t)(k0 + krow + 32 * ps) * N + n0 + col4 * 4));
    }
    for (; tile < last; tile += nw) {
        const float* W; bf16_t* Wt; int K, N, mode, local; conv_job(p, tile, W, Wt, K, N, mode, local);
        const int ntn = N >> 6, k0 = (local / ntn) * 128, n0 = (local % ntn) * 64;
#pragma unroll
        for (int ps = 0; ps < 4; ++ps) *(LAS f32x4*)(st + (krow + 32 * ps) * 68 + col4 * 4) = rg[ps];
        __syncthreads();
        const int nt2 = tile + nw;
        if (nt2 < last) {
            const float* W2; bf16_t* Wt2; int K2, N2, mode2, local2; conv_job(p, nt2, W2, Wt2, K2, N2, mode2, local2);
            const int ntn2 = N2 >> 6, k02 = (local2 / ntn2) * 128, n02 = (local2 % ntn2) * 64;
#pragma unroll
            for (int ps = 0; ps < 4; ++ps) rg[ps] = __builtin_nontemporal_load((const f32x4*)(W2 + (size_t)(k02 + krow + 32 * ps) * N2 + n02 + col4 * 4));
        }
        int c = n0 + nn, dest = c;
        if (mode == 1) { const int half = c >= FF ? 1 : 0; const int j = c - half * FF; dest = (j >> 7) * 256 + half * 128 + (j & 127); }
#pragma unroll
        for (int ps = 0; ps < 2; ++ps) {
            const int kgrp = kg + 8 * ps;
            float v[8];
#pragma unroll
            for (int j = 0; j < 8; ++j) v[j] = st[(kgrp * 8 + j) * 68 + nn];
            u32x4 wv; wv.x = cvt_pk_bf16(v[0], v[1]); wv.y = cvt_pk_bf16(v[2], v[3]); wv.z = cvt_pk_bf16(v[4], v[5]); wv.w = cvt_pk_bf16(v[6], v[7]);
            *(u32x4*)(Wt + (size_t)dest * K + k0 + kgrp * 8) = wv;
        }
        __syncthreads();
    }
}

__device__ __forceinline__ void prep_phase(const Params& p, LAS unsigned char* lds) {
    const int tid = opaque_tid();
    {
        LAS float* sl = (LAS float*)lds;
        LAS float* red = (LAS float*)(lds + 73728);
        for (int idx = tid; idx < 9 * 2048; idx += 512) { const int i = idx >> 11, k = idx & 2047; const float v = (i < 8) ? p.in[I_C][i * 2048 + k] : p.in[I_CCTX][k]; sl[idx] = silu_f(v); }
        __syncthreads();
        float* mod = (float*)(p.ws + OFF_MOD);
        for (int g = blockIdx.x; g < 256; g += gridDim.x) {
            const int gc = g * 96, l = gc / 12288, n0 = gc % 12288;
            if (tid < 384) {
                const int cg4 = tid % 24, kl = tid / 24;
                f32x4 acc[9];
#pragma unroll
                for (int i = 0; i < 9; ++i) acc[i] = (f32x4){0.f, 0.f, 0.f, 0.f};
                const float* wp = p.in[I_WADA] + ((size_t)l * 2048 + kl) * 12288 + n0 + cg4 * 4;
#pragma unroll 8
                for (int kk = 0; kk < 128; ++kk) {
                    const f32x4 w = __builtin_nontemporal_load((const f32x4*)(wp + (size_t)kk * 16 * 12288));
                    const int k = kl + 16 * kk;
#pragma unroll
                    for (int i = 0; i < 9; ++i) { const float s = sl[i * 2048 + k]; acc[i] += w * s; }
                }
#pragma unroll
                for (int i = 0; i < 9; ++i) *(LAS f32x4*)(red + (kl * 9 + i) * 96 + cg4 * 4) = acc[i];
            }
            __syncthreads();
            for (int o = tid; o < 864; o += 512) {
                const int i = o / 96, col = o % 96; float s = 0.f;
#pragma unroll
                for (int kl = 0; kl < 16; ++kl) s += red[(kl * 9 + i) * 96 + col];
                mod[(size_t)(l * 9 + i) * 12288 + n0 + col] = s + p.in[I_BADA][l * 12288 + n0 + col];
            }
            __syncthreads();
        }
    }
    convert_range(p, lds, 0, N_CONV_TILES, (int)blockIdx.x, (int)gridDim.x);
}

__device__ __forceinline__ float wave_sum(float v) {
#pragma unroll
    for (int o = 32; o >= 1; o >>= 1) v += __shfl_xor(v, o);
    return v;
}
__device__ __forceinline__ void mod_phase(const Params& p, int layer, int which, int nrows, int src_mode, const float* part = nullptr, const float* rin_ctx = nullptr, const float* gate_ctx = nullptr) {
    const int tid = opaque_tid(); const int lane = tid & 63, wave = blockIdx.x * 8 + (tid >> 6), nw = gridDim.x * 8;
    const float* g = (which ? p.in[I_GFFN] : p.in[I_GMIX]) + layer * 2048;
    const float* mod = (const float*)(p.ws + OFF_MOD);
    bf16_t* A0 = (bf16_t*)(p.ws + OFF_A0);
    const float* lat = src_mode ? p.out : p.in[I_X];
    const float* ctx = src_mode ? (const float*)(p.ws + OFF_XC) : p.in[I_CTX];
    f32x4 mg[8];
#pragma unroll
    for (int j = 0; j < 8; ++j) mg[j] = *(const f32x4*)(g + lane * 4 + 256 * j);
    f32x4 vn[8];
    int r = wave;
    bool have = (r < nrows) && !(part != nullptr && r >= ML);
    if (have) { const float* src = (r < ML) ? lat + (size_t)r * 2048 : ctx + (size_t)(r - ML) * 2048;
#pragma unroll
        for (int j = 0; j < 8; ++j) vn[j] = __builtin_nontemporal_load((const f32x4*)(src + lane * 4 + 256 * j)); }
    for (; r < nrows; r += nw) {
        const int bi = (r < ML) ? (r >> 11) : 8;
        const float* sh = mod + (size_t)(layer * 9 + bi) * 12288 + (which ? 3 : 0) * 2048;
        const float* sc = sh + 2048;
        f32x4 v[8]; float ss = 0.f;
        if (have) {
#pragma unroll
            for (int j = 0; j < 8; ++j) v[j] = vn[j];
        } else {
            const size_t ro = (size_t)(r - ML) * 2048; float* xc = (float*)(p.ws + OFF_XC) + ro;
#pragma unroll
            for (int j = 0; j < 8; ++j) { const int col = lane * 4 + 256 * j;
                const f32x4 s4 = (*(const f32x4*)(part + ro + col) + *(const f32x4*)(part + (size_t)MC * 2048 + ro + col)) + (*(const f32x4*)(part + (size_t)2 * MC * 2048 + ro + col) + *(const f32x4*)(part + (size_t)3 * MC * 2048 + ro + col));
                v[j] = *(const f32x4*)(rin_ctx + ro + col) + *(const f32x4*)(gate_ctx + col) * s4;
                *(f32x4*)(xc + col) = v[j]; }
        }
        f32x4 m1[8], m0[8];
#pragma unroll
        for (int j = 0; j < 8; ++j) { const int col = lane * 4 + 256 * j; m1[j] = *(const f32x4*)(sc + col); m0[j] = *(const f32x4*)(sh + col); }
        { const int rn = r + nw; have = (rn < nrows) && !(part != nullptr && rn >= ML);
          if (have) { const float* src = (rn < ML) ? lat + (size_t)rn * 2048 : ctx + (size_t)(rn - ML) * 2048;
#pragma unroll
              for (int j = 0; j < 8; ++j) vn[j] = __builtin_nontemporal_load((const f32x4*)(src + lane * 4 + 256 * j)); } }
#pragma unroll
        for (int j = 0; j < 8; ++j) ss += v[j][0] * v[j][0] + v[j][1] * v[j][1] + v[j][2] * v[j][2] + v[j][3] * v[j][3];
        ss = wave_sum(ss);
        const float rstd = rsqrtf(ss * (1.0f / 2048.0f) + 1e-6f);
#pragma unroll
        for (int j = 0; j < 8; ++j) {
            const int col = lane * 4 + 256 * j;
            const f32x4 y = (v[j] * rstd) * mg[j] * (m1[j] + 1.0f) + m0[j];
            u32x2 w; w.x = cvt_pk_bf16(y[0], y[1]); w.y = cvt_pk_bf16(y[2], y[3]);
            *(u32x2*)(A0 + (size_t)r * 2048 + col) = w;
        }
    }
}

__device__ __forceinline__ void final_phase(const Params& p) {
    const int tid = opaque_tid(); const int lane = tid & 63, wave = blockIdx.x * 8 + (tid >> 6), nw = gridDim.x * 8;
    const float* g = p.in[I_GFINAL];
    f32x4 gg[8];
#pragma unroll
    for (int j = 0; j < 8; ++j) gg[j] = *(const f32x4*)(g + lane * 4 + 256 * j);
    f32x4 vn[8];
    int r = wave;
    if (r < ML) {
#pragma unroll
        for (int j = 0; j < 8; ++j) vn[j] = __builtin_nontemporal_load((const f32x4*)(p.out + (size_t)r * 2048 + lane * 4 + 256 * j)); }
    for (; r < ML; r += nw) {
        float* src = p.out + (size_t)r * 2048;
        f32x4 v[8]; float ss = 0.f;
#pragma unroll
        for (int j = 0; j < 8; ++j) { v[j] = vn[j]; ss += v[j][0] * v[j][0] + v[j][1] * v[j][1] + v[j][2] * v[j][2] + v[j][3] * v[j][3]; }
        if (r + nw < ML) {
#pragma unroll
            for (int j = 0; j < 8; ++j) vn[j] = __builtin_nontemporal_load((const f32x4*)(p.out + (size_t)(r + nw) * 2048 + lane * 4 + 256 * j)); }
        ss = wave_sum(ss);
        const float rstd = rsqrtf(ss * (1.0f / 2048.0f) + 1e-6f);
#pragma unroll
        for (int j = 0; j < 8; ++j) { const int col = lane * 4 + 256 * j; *(f32x4*)(src + col) = (v[j] * rstd) * gg[j]; }
    }
}

struct EpiBf16 {
    static constexpr bool PERM = true, AFTER_DRAIN = false;
    bf16_t* O; int ldc;
    __device__ __forceinline__ void operator()(const f32x4 (&acc)[2][2][4][2], const Unit& u, int wr, int wc, int fr, int fq) const {
        const int row0 = u.pm * 256 + wr * 64 + fr, col0 = u.pn * 256 + wc * 32 + 8 * fq;
#pragma unroll
        for (int ai = 0; ai < 2; ++ai)
#pragma unroll
            for (int m = 0; m < 4; ++m) { bf16_t* rowp = O + (size_t)(row0 + ai * 128 + m * 16) * ldc + col0;
#pragma unroll
                for (int bj = 0; bj < 2; ++bj) { const f32x4 v0 = acc[ai][bj][m][0], v1 = acc[ai][bj][m][1];
                    u32x4 w; w.x = cvt_pk_bf16(v0[0], v0[1]); w.y = cvt_pk_bf16(v0[2], v0[3]); w.z = cvt_pk_bf16(v1[0], v1[1]); w.w = cvt_pk_bf16(v1[2], v1[3]);
                    *(u32x4*)(rowp + bj * 128) = w; } }
    }
};
struct EpiSwiglu {
    static constexpr bool PERM = true, AFTER_DRAIN = false;
    bf16_t* O; int ldc;
    __device__ __forceinline__ void operator()(const f32x4 (&acc)[2][2][4][2], const Unit& u, int wr, int wc, int fr, int fq) const {
        const int row0 = u.pm * 256 + wr * 64 + fr, col0 = u.pn * 128 + wc * 32 + 8 * fq;
#pragma unroll
        for (int ai = 0; ai < 2; ++ai)
#pragma unroll
            for (int m = 0; m < 4; ++m) { bf16_t* rowp = O + (size_t)(row0 + ai * 128 + m * 16) * ldc + col0;
                const f32x4 g0 = acc[ai][0][m][0], g1 = acc[ai][0][m][1], u0 = acc[ai][1][m][0], u1 = acc[ai][1][m][1];
                float y[8];
#pragma unroll
                for (int j = 0; j < 4; ++j) { y[j] = silu_f(g0[j]) * u0[j]; y[4 + j] = silu_f(g1[j]) * u1[j]; }
                u32x4 w; w.x = cvt_pk_bf16(y[0], y[1]); w.y = cvt_pk_bf16(y[2], y[3]); w.z = cvt_pk_bf16(y[4], y[5]); w.w = cvt_pk_bf16(y[6], y[7]);
                *(u32x4*)rowp = w; }
    }
};
struct EpiResid {
    static constexpr bool PERM = false, AFTER_DRAIN = false;
    const float* in_lat; const float* in_ctx; float* out_lat; float* out_ctx; const float* gate;
    __device__ __forceinline__ void operator()(const f32x4 (&acc)[2][2][4][2], const Unit& u, int wr, int wc, int fr, int fq) const {
        const int row0 = u.pm * 256 + wr * 64 + fr, col0 = u.pn * 256 + wc * 32 + 4 * fq;
        const bool isl = u.pm < 64; const int bi = isl ? (u.pm >> 3) : 8;
        const float* gp = gate + (size_t)bi * 12288 + col0;
        f32x4 gv[2][2];
#pragma unroll
        for (int bj = 0; bj < 2; ++bj)
#pragma unroll
            for (int n = 0; n < 2; ++n) gv[bj][n] = *(const f32x4*)(gp + bj * 128 + n * 16);
        const float* ibase = (isl ? in_lat + (size_t)row0 * 2048 : in_ctx + (size_t)(row0 - ML) * 2048) + col0;
        float* obase = (isl ? out_lat + (size_t)row0 * 2048 : out_ctx + (size_t)(row0 - ML) * 2048) + col0;
#pragma unroll
        for (int ai = 0; ai < 2; ++ai) {
            f32x4 rv[4][2][2];
#pragma unroll
            for (int m = 0; m < 4; ++m)
#pragma unroll
                for (int bj = 0; bj < 2; ++bj)
#pragma unroll
                    for (int n = 0; n < 2; ++n) rv[m][bj][n] = *(const f32x4*)(ibase + (size_t)(ai * 128 + m * 16) * 2048 + bj * 128 + n * 16);
#pragma unroll
            for (int m = 0; m < 4; ++m)
#pragma unroll
                for (int bj = 0; bj < 2; ++bj)
#pragma unroll
                    for (int n = 0; n < 2; ++n) *(f32x4*)(obase + (size_t)(ai * 128 + m * 16) * 2048 + bj * 128 + n * 16) = rv[m][bj][n] + gv[bj][n] * acc[ai][bj][m][n];
        }
    }
};

struct SchedHgIn {
    pg8::StaticOrder lat; int G, c;
    __device__ void init(int G_, int c_) { lat.init(ML, 10240, G_, c_); G = G_; c = c_; }
    __device__ bool next(int i, Unit& u) const {
        const long L = (long)i * G + c;
        if (L < lat.nwg) return lat.next(i, u);
        const int r = (int)(L - lat.nwg); if (r >= 8 * 24) return false;
        u.pm = 64 + (r & 7); u.pn = 8 + (r >> 3); return true;
    }
    __device__ __forceinline__ void a_ready(const Unit&) const {}
    __device__ __forceinline__ void done(const Unit&) const {}
};
template <class Epi> __device__ __forceinline__ void run_gemm(LAS unsigned char* lds, const bf16_t* A, const bf16_t* Bt, int M, int N, int K, const Epi& E) {
    pg8::Gemm g; g.A = A; g.Bt = Bt; g.M = M; g.N = N; g.K = K; g.ld = K;
    pg8::StaticOrder S; S.init(M, N, (int)gridDim.x, (int)blockIdx.x);
    pg8::gemm_phase<Epi, pg8::StaticOrder, GEMM_ALIGN, GEMM_SP2>(lds, g, S, E);
}

struct SchedOne { int pm, pn; bool has;
    __device__ bool next(int i, Unit& u) const { if (i != 0 || !has) return false; u.pm = pm; u.pn = pn; return true; }
    __device__ __forceinline__ void a_ready(const Unit&) const {}
    __device__ __forceinline__ void done(const Unit&) const {} };
struct EpiPartial { static constexpr bool PERM = false, AFTER_DRAIN = false; float* P;
    __device__ __forceinline__ void operator()(const f32x4 (&acc)[2][2][4][2], const Unit& u, int wr, int wc, int fr, int fq) const {
        const int row0 = u.pm * 256 + wr * 64 + fr, col0 = u.pn * 256 + wc * 32 + 4 * fq;
#pragma unroll
        for (int ai = 0; ai < 2; ++ai)
#pragma unroll
            for (int m = 0; m < 4; ++m) { float* rowp = P + (size_t)(row0 + ai * 128 + m * 16) * 2048 + col0;
#pragma unroll
                for (int bj = 0; bj < 2; ++bj)
#pragma unroll
                    for (int n = 0; n < 2; ++n) *(f32x4*)(rowp + bj * 128 + n * 16) = acc[ai][bj][m][n]; } } };
__device__ __forceinline__ void splitk_ctx_gemm(LAS unsigned char* lds, const Params& p, const bf16_t* A, const bf16_t* Bt, int K) {
    const int c = (int)blockIdx.x, j = c >> 2, s = c & 3, Kq = K >> 2;
    pg8::Gemm g; g.A = A + (size_t)ML * K + (size_t)s * Kq; g.Bt = Bt + (size_t)s * Kq; g.M = MC; g.N = 2048; g.K = Kq; g.ld = K;
    SchedOne S; S.pm = j & 7; S.pn = j >> 3; S.has = c < 256;
    EpiPartial E; E.P = (float*)(p.ws + OFF_PART) + (size_t)s * MC * 2048;
    pg8::gemm_phase<EpiPartial, SchedOne, GEMM_ALIGN, GEMM_SP2>(lds, g, S, E);
}
__device__ __forceinline__ int rg_tok_row(int b, int dir, int s, int& tk, int& len, int& base) {
    if (s < CTXL) { tk = dir ? (CTXL - 1 - s) : s; len = CTXL; base = ML + b * CTXL; }
    else { const int s2 = s - CTXL; tk = dir ? (SEQ - 1 - s2) : s2; len = SEQ; base = b * SEQ; }
    return base + tk;
}
#define LDS_BARRIER() do { asm volatile("s_waitcnt lgkmcnt(0)" ::: "memory"); __builtin_amdgcn_s_barrier(); asm volatile("" ::: "memory"); } while (0)
__device__ __forceinline__ void rg_scan_phase(const Params& p, LAS unsigned char* lds) {
    const int tid = opaque_tid(), wid = tid >> 6, lane = tid & 63, fr = lane & 15, fq = lane >> 4;
    LAS bf16_t* sW = (LAS bf16_t*)lds;
    const bf16_t* XG = (const bf16_t*)(p.ws + OFF_BIG);
    for (int u = blockIdx.x; u < 256; u += gridDim.x) {
        const int b = u >> 5, h = (u >> 1) & 15, dir = u & 1;
        bf16_t* HO = (bf16_t*)(p.ws + (dir ? OFF_HB : OFF_A0));
        {
            const float* wa = p.in[I_RGWA] + (size_t)(dir * 16 + h) * 16384; const float* wi = p.in[I_RGWI] + (size_t)(dir * 16 + h) * 16384;
            for (int it = 0; it < 16; ++it) {
                const int idx = tid + 512 * it, mat = idx >> 12, rem = idx & 4095, e4 = rem >> 7, d = rem & 127;
                const f32x4 v = *(const f32x4*)((mat ? wi : wa) + d * 128 + e4 * 4);
#pragma unroll
                for (int j = 0; j < 4; ++j) sW[(mat * 128 + e4 * 4 + j) * 136 + d] = f2bf(v[j]);
            }
        }
        const int cch = 16 * wid + fr;
        const float ba = p.in[I_RGBA][(dir * 16 + h) * 128 + cch], bi_ = p.in[I_RGBI][(dir * 16 + h) * 128 + cch];
        const float nsp = -8.0f * 1.4426950408889634f * log1pf(expf(-p.in[I_RGLAM][dir * 2048 + h * 128 + cch]));
        float hc = 0.f;
        const int c8 = tid & 15;
        LAS float* sCW = (LAS float*)(lds + 69632 + 2 * 17408);
        for (int idx = tid; idx < 640; idx += 512) sCW[idx] = (idx < 512) ? p.in[I_RGCONVW][(idx >> 7) * 2048 + h * 128 + (idx & 127)] : p.in[I_RGCONVB][h * 128 + (idx - 512)];
        u32x4 xr[2][4];
#define RG_LOAD_TAPS(tile_) do { _Pragma("unroll") for (int ps = 0; ps < 2; ++ps) { const int i_ = (tid >> 4) + 32 * ps; int tk_, len_, base_; rg_tok_row(b, dir, (tile_) * 64 + i_, tk_, len_, base_); \
            _Pragma("unroll") for (int k = 0; k < 4; ++k) { const int tt_ = tk_ + k - 2; const bool ok_ = (tt_ >= 0) && (tt_ < len_); \
                xr[ps][k] = ok_ ? *(const u32x4*)(XG + (size_t)(base_ + (ok_ ? tt_ : tk_)) * 4096 + h * 128 + c8 * 8) : (u32x4){0u, 0u, 0u, 0u}; } } } while (0)
        RG_LOAD_TAPS(0);
        __syncthreads();
        for (int tile = 0; tile < 36; ++tile) {
            LAS bf16_t* sA = (LAS bf16_t*)(lds + 69632 + (tile & 1) * 17408);
#pragma unroll
            for (int ps = 0; ps < 2; ++ps) {
                const int i = (tid >> 4) + 32 * ps;
                float xc[8];
                { const f32x4 c0 = *(const LAS f32x4*)(sCW + 512 + c8 * 8), c1 = *(const LAS f32x4*)(sCW + 512 + c8 * 8 + 4);
                  xc[0] = c0[0]; xc[1] = c0[1]; xc[2] = c0[2]; xc[3] = c0[3]; xc[4] = c1[0]; xc[5] = c1[1]; xc[6] = c1[2]; xc[7] = c1[3]; }
#pragma unroll
                for (int k = 0; k < 4; ++k) { const u32x4 raw = xr[ps][k];
                    const f32x4 w0 = *(const LAS f32x4*)(sCW + k * 128 + c8 * 8), w1 = *(const LAS f32x4*)(sCW + k * 128 + c8 * 8 + 4);
                    xc[0] += w0[0] * bflo(raw.x); xc[1] += w0[1] * bfhi(raw.x); xc[2] += w0[2] * bflo(raw.y); xc[3] += w0[3] * bfhi(raw.y);
                    xc[4] += w1[0] * bflo(raw.z); xc[5] += w1[1] * bfhi(raw.z); xc[6] += w1[2] * bflo(raw.w); xc[7] += w1[3] * bfhi(raw.w); }
                u32x4 w; w.x = cvt_pk_bf16(xc[0], xc[1]); w.y = cvt_pk_bf16(xc[2], xc[3]); w.z = cvt_pk_bf16(xc[4], xc[5]); w.w = cvt_pk_bf16(xc[6], xc[7]);
                *(LAS u32x4*)(sA + i * 136 + c8 * 8) = w;
            }
            if (tile + 1 < 36) RG_LOAD_TAPS(tile + 1);
            LDS_BARRIER();
            f32x4 aR[4], aI[4];
#pragma unroll
            for (int tt = 0; tt < 4; ++tt) { aR[tt] = (f32x4){0.f, 0.f, 0.f, 0.f}; aI[tt] = (f32x4){0.f, 0.f, 0.f, 0.f}; }
#pragma unroll
            for (int kk = 0; kk < 4; ++kk) {
                const bf16x8 wa_f = *(const LAS bf16x8*)(sW + (16 * wid + fr) * 136 + kk * 32 + fq * 8);
                const bf16x8 wi_f = *(const LAS bf16x8*)(sW + (128 + 16 * wid + fr) * 136 + kk * 32 + fq * 8);
#pragma unroll
                for (int tt = 0; tt < 4; ++tt) { const bf16x8 xf = *(const LAS bf16x8*)(sA + (tt * 16 + fr) * 136 + kk * 32 + fq * 8);
                    aR[tt] = __builtin_amdgcn_mfma_f32_16x16x32_bf16(xf, wa_f, aR[tt], 0, 0, 0);
                    aI[tt] = __builtin_amdgcn_mfma_f32_16x16x32_bf16(xf, wi_f, aI[tt], 0, 0, 0); }
            }
            int tk0, len0, base0; const int rb0 = rg_tok_row(b, dir, tile * 64, tk0, len0, base0);
#pragma unroll
            for (int tt = 0; tt < 4; ++tt) {
                float Ap[4], Bp[4];
#pragma unroll
                for (int i = 0; i < 4; ++i) {
                    const int it = tt * 16 + 4 * fq + i;
                    const float xv = bf2f(sA[it * 136 + cch]);
                    const float r = sigm(aR[tt][i] + ba), ig = sigm(aI[tt][i] + bi_);
                    const float a = fexp2(nsp * r), bb = __builtin_amdgcn_sqrtf(fmaxf(1.0f - a * a, 0.f)) * ig * xv;
                    if (i == 0) { Ap[0] = a; Bp[0] = bb; } else { Ap[i] = Ap[i - 1] * a; Bp[i] = fmaf(a, Bp[i - 1], bb); }
                }
                float Ag = Ap[3], Bg = Bp[3];
                { const float ap = __shfl_up(Ag, 16), bp = __shfl_up(Bg, 16); if (fq >= 1) { Bg = fmaf(Ag, bp, Bg); Ag *= ap; } }
                { const float ap = __shfl_up(Ag, 32), bp = __shfl_up(Bg, 32); if (fq >= 2) { Bg = fmaf(Ag, bp, Bg); Ag *= ap; } }
                float Ae = __shfl_up(Ag, 16), Be = __shfl_up(Bg, 16); if (fq == 0) { Ae = 1.0f; Be = 0.f; }
                const float At = __shfl(Ag, fr + 48), Bt = __shfl(Bg, fr + 48);
                const float hin = fmaf(Ae, hc, Be);
                hc = fmaf(At, hc, Bt);
#pragma unroll
                for (int i = 0; i < 4; ++i) {
                    const int it = tt * 16 + 4 * fq + i; const int row = rb0 + (dir ? -it : it);
                    HO[(size_t)row * 2048 + h * 128 + cch] = f2bf(fmaf(Ap[i], hin, Bp[i]));
                }
            }
        }
        __syncthreads();
    }
}
__device__ __forceinline__ void rg_combine_phase(const Params& p) {
    bf16_t* HF = (bf16_t*)(p.ws + OFF_A0); const bf16_t* HB = (const bf16_t*)(p.ws + OFF_HB); const bf16_t* XG = (const bf16_t*)(p.ws + OFF_BIG);
    const size_t n8 = (size_t)MT * 256, gsz = (size_t)gridDim.x * 512;
    const int tid = opaque_tid();
    u32x4 an[4], bn[4], gn[4];
#define RGC_LOAD(i0_) do { _Pragma("unroll") for (int k = 0; k < 4; ++k) { const size_t i = (i0_) + k * gsz; if (i < n8) { const size_t r = i >> 8; const int c = (int)(i & 255) * 8; \
        an[k] = __builtin_nontemporal_load((const u32x4*)(HF + r * 2048 + c)); bn[k] = __builtin_nontemporal_load((const u32x4*)(HB + r * 2048 + c)); gn[k] = __builtin_nontemporal_load((const u32x4*)(XG + r * 4096 + 2048 + c)); } } } while (0)
    size_t i0 = (size_t)blockIdx.x * 512 + tid;
    RGC_LOAD(i0);
    for (; i0 < n8; i0 += gsz * 4) {
        u32x4 a[4], bq[4], gq[4];
#pragma unroll
        for (int k = 0; k < 4; ++k) { a[k] = an[k]; bq[k] = bn[k]; gq[k] = gn[k]; }
        if (i0 + gsz * 4 < n8) RGC_LOAD(i0 + gsz * 4);
#pragma unroll
        for (int k = 0; k < 4; ++k) { const size_t i = i0 + k * gsz; if (i < n8) { const size_t r = i >> 8; const int c = (int)(i & 255) * 8;
            u32x4 w;
            w.x = cvt_pk_bf16((bflo(a[k].x) + bflo(bq[k].x)) * gelu_tanh_f(bflo(gq[k].x)), (bfhi(a[k].x) + bfhi(bq[k].x)) * gelu_tanh_f(bfhi(gq[k].x)));
            w.y = cvt_pk_bf16((bflo(a[k].y) + bflo(bq[k].y)) * gelu_tanh_f(bflo(gq[k].y)), (bfhi(a[k].y) + bfhi(bq[k].y)) * gelu_tanh_f(bfhi(gq[k].y)));
            w.z = cvt_pk_bf16((bflo(a[k].z) + bflo(bq[k].z)) * gelu_tanh_f(bflo(gq[k].z)), (bfhi(a[k].z) + bfhi(bq[k].z)) * gelu_tanh_f(bfhi(gq[k].z)));
            w.w = cvt_pk_bf16((bflo(a[k].w) + bflo(bq[k].w)) * gelu_tanh_f(bflo(gq[k].w)), (bfhi(a[k].w) + bfhi(bq[k].w)) * gelu_tanh_f(bfhi(gq[k].w)));
            *(u32x4*)(HF + r * 2048 + c) = w; } }
    }
#undef RGC_LOAD
}

__device__ __forceinline__ int hg_tok_row(int b, int dir, int s) {
    if (s < CTXL) return ML + b * CTXL + (dir ? (CTXL - 1 - s) : s);
    int i = s - CTXL; if (dir) i = SEQ - 1 - i;
    const int w = i >> 5, r = i & 31;
    return b * SEQ + r * 64 + w;
}
__device__ __forceinline__ bf16x8 as_bf16x8(u32x4 v) { return __builtin_bit_cast(bf16x8, v); }
__device__ __forceinline__ void hg_scan_mfma(const Params& p, LAS unsigned char* lds) {
    const int tid = opaque_tid(), wid = tid >> 6, lane = tid & 63, fr = lane & 15, fq = lane >> 4;
    const bf16_t* QF = (const bf16_t*)(p.ws + OFF_BIG);
    constexpr int BUFB = 38400;
    for (int u = blockIdx.x; u < 256; u += gridDim.x) {
        const int b = u >> 5, h = (u >> 1) & 15, dir = u & 1;
        bf16_t* OO = (bf16_t*)(p.ws + (dir ? OFF_HB : OFF_A0));
        const int dch = 16 * wid + fr;
        const float lb = sigm(p.in[I_HGLB][4096 + dir * 2048 + h * 128 + dch] - p.in[I_HGLB][dir * 2048 + h * 128 + dch]);
        f32x4 S[8];
#pragma unroll
        for (int T = 0; T < 8; ++T) S[T] = (f32x4){0.f, 0.f, 0.f, 0.f};
        unsigned rq[8], rz[8], rv[8];
        unsigned rbo[8];
#pragma unroll
        for (int t = 0; t < 8; ++t) { const int rr = 8 * fq + t, rr2 = dir ? 31 - rr : rr; rbo[t] = (unsigned)rr2 * 20480u + (unsigned)dch * 2u; }
#define HG_ROWBASE(c_) (((c_) < 8) ? (ML + b * CTXL + (dir ? (CTXL - 32 - 32 * (c_)) : 32 * (c_))) : (b * SEQ + (dir ? (63 - ((c_) - 8)) : ((c_) - 8))))
#define HG_LOAD_RAW(c_) do { const char* qb_ = (const char*)(QF + (size_t)HG_ROWBASE(c_) * 10240 + h * 128); const char* zb_ = qb_ + (1 + dir) * 4096; const char* vb_ = qb_ + 12288; \
            _Pragma("unroll") for (int t = 0; t < 8; ++t) { rq[t] = *(const bf16_t*)(qb_ + rbo[t]); rz[t] = *(const bf16_t*)(zb_ + rbo[t]); rv[t] = *(const bf16_t*)(vb_ + rbo[t]); } } while (0)
#define HG_PREP(BO) do { LAS unsigned char* buf_ = lds + (BO); LAS bf16_t* sQ = (LAS bf16_t*)buf_; LAS bf16_t* sK = (LAS bf16_t*)(buf_ + 8704); LAS bf16_t* sKh = (LAS bf16_t*)(buf_ + 17408); \
            LAS bf16_t* sVT = (LAS bf16_t*)(buf_ + 27648); LAS float* sDec = (LAS float*)(buf_ + 37888); \
            float bl[8], kk[8]; float run = 0.f; \
            _Pragma("unroll") for (int t = 0; t < 8; ++t) { const float f = lb + (1.0f - lb) * sigm(bf2f(rz[t])); kk[t] = 1.0f - f; run += __builtin_amdgcn_logf(f); bl[t] = run; } \
            const float t0 = __shfl(run, fr), t1 = __shfl(run, fr + 16), t2 = __shfl(run, fr + 32), t3 = __shfl(run, fr + 48); \
            const float off = (fq > 0 ? t0 : 0.f) + (fq > 1 ? t1 : 0.f) + (fq > 2 ? t2 : 0.f), blast = (t0 + t1) + (t2 + t3); \
            float kh[8]; const float dlast = fexp2(blast); \
            _Pragma("unroll") for (int t = 0; t < 8; ++t) { const float bt = bl[t] + off; const float eb = fexp2(bt), ieb = frcp(eb); const float qt = bf2f(rq[t]) * 0.08838834764831845f * eb, kt = kk[t] * ieb; kh[t] = kt * dlast; \
                sQ[(8 * fq + t) * 136 + dch] = f2bf(qt); sK[(8 * fq + t) * 136 + dch] = f2bf(kt); } \
            u32x4 w; w.x = cvt_pk_bf16(kh[0], kh[1]); w.y = cvt_pk_bf16(kh[2], kh[3]); w.z = cvt_pk_bf16(kh[4], kh[5]); w.w = cvt_pk_bf16(kh[6], kh[7]); \
            *(LAS u32x4*)(sKh + dch * 40 + 8 * fq) = w; \
            u32x4 vw; vw.x = rv[0] | (rv[1] << 16); vw.y = rv[2] | (rv[3] << 16); vw.z = rv[4] | (rv[5] << 16); vw.w = rv[6] | (rv[7] << 16); \
            *(LAS u32x4*)(sVT + dch * 40 + 8 * fq) = vw; \
            if (fq == 0) sDec[dch] = dlast; } while (0)
#define HG_OUT(BO, c_) do { LAS unsigned char* buf_ = lds + (BO); LAS bf16_t* sQ = (LAS bf16_t*)buf_; LAS bf16_t* sK = (LAS bf16_t*)(buf_ + 8704); LAS bf16_t* sVT = (LAS bf16_t*)(buf_ + 27648); \
            f32x4 T00 = (f32x4){0.f, 0.f, 0.f, 0.f}, T01 = T00, T11 = T00; \
            _Pragma("unroll") for (int kk = 0; kk < 4; ++kk) { \
                const bf16x8 ak0 = *(const LAS bf16x8*)(sK + fr * 136 + 32 * kk + 8 * fq), ak1 = *(const LAS bf16x8*)(sK + (16 + fr) * 136 + 32 * kk + 8 * fq); \
                const bf16x8 bq0 = *(const LAS bf16x8*)(sQ + fr * 136 + 32 * kk + 8 * fq), bq1 = *(const LAS bf16x8*)(sQ + (16 + fr) * 136 + 32 * kk + 8 * fq); \
                T00 = __builtin_amdgcn_mfma_f32_16x16x32_bf16(ak0, bq0, T00, 0, 0, 0); \
                T01 = __builtin_amdgcn_mfma_f32_16x16x32_bf16(ak0, bq1, T01, 0, 0, 0); \
                T11 = __builtin_amdgcn_mfma_f32_16x16x32_bf16(ak1, bq1, T11, 0, 0, 0); } \
            _Pragma("unroll") for (int i = 0; i < 4; ++i) if (4 * fq + i > fr) { T00[i] = 0.f; T11[i] = 0.f; } \
            u32x4 P0, P1; \
            P0.x = cvt_pk_bf16(T00[0], T00[1]); P0.y = cvt_pk_bf16(T00[2], T00[3]); P0.z = 0u; P0.w = 0u; \
            P1.x = cvt_pk_bf16(T01[0], T01[1]); P1.y = cvt_pk_bf16(T01[2], T01[3]); P1.z = cvt_pk_bf16(T11[0], T11[1]); P1.w = cvt_pk_bf16(T11[2], T11[3]); \
            f32x4 O0 = (f32x4){0.f, 0.f, 0.f, 0.f}, O1 = O0; \
            { const u32x2 vlo = *(const LAS u32x2*)(sVT + dch * 40 + 4 * fq), vhi = *(const LAS u32x2*)(sVT + dch * 40 + 16 + 4 * fq); \
              u32x4 av; av.x = vlo.x; av.y = vlo.y; av.z = vhi.x; av.w = vhi.y; \
              O0 = __builtin_amdgcn_mfma_f32_16x16x32_bf16(as_bf16x8(av), as_bf16x8(P0), O0, 0, 0, 0); \
              O1 = __builtin_amdgcn_mfma_f32_16x16x32_bf16(as_bf16x8(av), as_bf16x8(P1), O1, 0, 0, 0); } \
            _Pragma("unroll") for (int kk = 0; kk < 4; ++kk) { \
                u32x4 as; as.x = cvt_pk_bf16(S[2 * kk][0], S[2 * kk][1]); as.y = cvt_pk_bf16(S[2 * kk][2], S[2 * kk][3]); \
                as.z = cvt_pk_bf16(S[2 * kk + 1][0], S[2 * kk + 1][1]); as.w = cvt_pk_bf16(S[2 * kk + 1][2], S[2 * kk + 1][3]); \
                const u32x2 q0l = *(const LAS u32x2*)(sQ + fr * 136 + 32 * kk + 4 * fq), q0h = *(const LAS u32x2*)(sQ + fr * 136 + 32 * kk + 16 + 4 * fq); \
                const u32x2 q1l = *(const LAS u32x2*)(sQ + (16 + fr) * 136 + 32 * kk + 4 * fq), q1h = *(const LAS u32x2*)(sQ + (16 + fr) * 136 + 32 * kk + 16 + 4 * fq); \
                u32x4 b0; b0.x = q0l.x; b0.y = q0l.y; b0.z = q0h.x; b0.w = q0h.y; \
                u32x4 b1; b1.x = q1l.x; b1.y = q1l.y; b1.z = q1h.x; b1.w = q1h.y; \
                O0 = __builtin_amdgcn_mfma_f32_16x16x32_bf16(as_bf16x8(as), as_bf16x8(b0), O0, 0, 0, 0); \
                O1 = __builtin_amdgcn_mfma_f32_16x16x32_bf16(as_bf16x8(as), as_bf16x8(b1), O1, 0, 0, 0); } \
            { const int rb_ = HG_ROWBASE(c_); const int row0 = rb_ + (dir ? 31 - fr : fr) * 64, row1 = rb_ + (dir ? 15 - fr : 16 + fr) * 64; \
              u32x2 w0; w0.x = cvt_pk_bf16(O0[0], O0[1]); w0.y = cvt_pk_bf16(O0[2], O0[3]); \
              u32x2 w1; w1.x = cvt_pk_bf16(O1[0], O1[1]); w1.y = cvt_pk_bf16(O1[2], O1[3]); \
              *(u32x2*)(OO + (size_t)row0 * 2048 + h * 128 + 16 * wid + 4 * fq) = w0; \
              *(u32x2*)(OO + (size_t)row1 * 2048 + h * 128 + 16 * wid + 4 * fq) = w1; } } while (0)
#define HG_UPD(BO) do { LAS unsigned char* buf_ = lds + (BO); LAS bf16_t* sKh = (LAS bf16_t*)(buf_ + 17408); LAS bf16_t* sVT = (LAS bf16_t*)(buf_ + 27648); LAS float* sDec = (LAS float*)(buf_ + 37888); \
            const bf16x8 bv = *(const LAS bf16x8*)(sVT + dch * 40 + 8 * fq); \
            _Pragma("unroll") for (int T = 0; T < 8; ++T) { \
                const f32x4 dec = *(const LAS f32x4*)(sDec + 16 * T + 4 * fq); \
                const bf16x8 akh = *(const LAS bf16x8*)(sKh + (16 * T + fr) * 40 + 8 * fq); \
                S[T] = __builtin_amdgcn_mfma_f32_16x16x32_bf16(akh, bv, S[T] * dec, 0, 0, 0); } } while (0)
        HG_LOAD_RAW(0); HG_PREP(0); HG_LOAD_RAW(1);
        for (int c = 0; c < 8; c += 2) {
            LDS_BARRIER(); HG_UPD(0); HG_PREP(BUFB);
            if (c + 2 == 8) {
#pragma unroll
                for (int t = 0; t < 8; ++t) { const int rr = 8 * fq + t, rr2 = dir ? 31 - rr : rr; rbo[t] = (unsigned)rr2 * (64u * 20480u) + (unsigned)dch * 2u; }
            }
            HG_LOAD_RAW(c + 2);
            LDS_BARRIER(); HG_UPD(BUFB); HG_PREP(0); HG_LOAD_RAW(c + 3);
        }
        for (int c = 8; c < 72; c += 2) {
            LDS_BARRIER(); HG_OUT(0, c); HG_UPD(0); HG_PREP(BUFB);
            if (c + 2 < 72) HG_LOAD_RAW(c + 2);
            LDS_BARRIER(); HG_OUT(BUFB, c + 1); HG_UPD(BUFB);
            if (c + 2 < 72) { HG_PREP(0); if (c + 3 < 72) HG_LOAD_RAW(c + 3); }
        }
        __syncthreads();
    }
}
__device__ __forceinline__ void hg_combine_phase(const Params& p) {
    const int tid = opaque_tid(); const int lane = tid & 63, wave = blockIdx.x * 8 + (tid >> 6), nw = gridDim.x * 8;
    bf16_t* OF = (bf16_t*)(p.ws + OFF_A0); const bf16_t* OB = (const bf16_t*)(p.ws + OFF_HB); const bf16_t* QF = (const bf16_t*)(p.ws + OFF_BIG);
    const int e4 = (lane & 31) * 4;
    const f32x4 nw4 = *(const f32x4*)(p.in[I_HGNORM] + e4);
    for (int pr0 = wave; pr0 < ML * 8; pr0 += nw * 8) {
        u32x2 a[8], bq[8], gq[8];
#pragma unroll
        for (int k = 0; k < 8; ++k) { const int pr = pr0 + k * nw; if (pr < ML * 8) { const int r = pr >> 3, col = ((pr & 7) * 2 + (lane >> 5)) * 128 + e4;
            a[k] = __builtin_nontemporal_load((const u32x2*)(OF + (size_t)r * 2048 + col)); bq[k] = __builtin_nontemporal_load((const u32x2*)(OB + (size_t)r * 2048 + col)); gq[k] = __builtin_nontemporal_load((const u32x2*)(QF + (size_t)r * 10240 + 4 * 2048 + col)); } }
#pragma unroll
        for (int k = 0; k < 8; ++k) { const int pr = pr0 + k * nw; if (pr < ML * 8) { const int r = pr >> 3, col = ((pr & 7) * 2 + (lane >> 5)) * 128 + e4;
            float o[4] = {bflo(a[k].x) + bflo(bq[k].x), bfhi(a[k].x) + bfhi(bq[k].x), bflo(a[k].y) + bflo(bq[k].y), bfhi(a[k].y) + bfhi(bq[k].y)};
            float ss = o[0] * o[0] + o[1] * o[1] + o[2] * o[2] + o[3] * o[3];
#pragma unroll
            for (int off = 16; off >= 1; off >>= 1) ss += __shfl_xor(ss, off);
            const float rstd = rsqrtf(ss * (1.0f / 128.0f) + 1e-6f);
            const float g[4] = {bflo(gq[k].x), bfhi(gq[k].x), bflo(gq[k].y), bfhi(gq[k].y)};
            float y[4];
#pragma unroll
            for (int j = 0; j < 4; ++j) y[j] = o[j] * rstd * nw4[j] * silu_f(g[j]);
            u32x2 w; w.x = cvt_pk_bf16(y[0], y[1]); w.y = cvt_pk_bf16(y[2], y[3]);
            *(u32x2*)(OF + (size_t)r * 2048 + col) = w; } }
    }
}

#define XB_TMO      128
#define XB_XCNT(j)  (256  + 64 * (j))
#define XB_XSUB(j)  (1280 + 64 * (j))
#define XB_XGEN(j)  (2304 + 64 * (j))
#define XB_TOP      3328
#define XB_TOPGEN   3392
#define XCD_BAR_WORDS 3456
#define XB_SPIN_CAP (1u << 18)

__device__ __forceinline__ unsigned xb_ld(unsigned* p)              { return __hip_atomic_load(p, __ATOMIC_RELAXED, __HIP_MEMORY_SCOPE_AGENT); }
__device__ __forceinline__ unsigned xb_add(unsigned* p, unsigned v) { return __hip_atomic_fetch_add(p, v, __ATOMIC_RELAXED, __HIP_MEMORY_SCOPE_AGENT); }
__device__ __forceinline__ unsigned xb_xcc_id() { return (unsigned)__builtin_amdgcn_s_getreg((3 << 11) | 20) & 0xFu; }
#define XB_SPIN(cond, bar) do { unsigned _sp = 0; while (cond) { __builtin_amdgcn_s_sleep(1); \
    if ((++_sp & 255u) == 0u) { if (xb_ld(&(bar)[XB_TMO])) break; if (_sp > XB_SPIN_CAP) { atomicAdd(&(bar)[XB_TMO], 1u); break; } } } } while (0)

struct XcdBarrier {
    unsigned* bar; unsigned x;
    volatile LAS unsigned* st;
};

__device__ __forceinline__ XcdBarrier xcd_barrier_post(unsigned* bar, volatile LAS unsigned* st) {
    XcdBarrier b; b.bar = bar; b.x = xb_xcc_id(); b.st = st;
    if (threadIdx.x == 0) (void)xb_add(&bar[XB_XCNT(b.x)], 1u);
    return b;
}
__device__ __forceinline__ void xcd_barrier_complete(unsigned* bar, unsigned x, unsigned& nloc, unsigned& nx) {
    const unsigned G = gridDim.x * gridDim.y * gridDim.z;
    unsigned sum, cnt, mine, sp = 0u;
    for (;;) {
        sum = 0u; cnt = 0u; mine = 0u;
#pragma unroll
        for (unsigned j = 0; j < 16; ++j) { const unsigned c = xb_ld(&bar[XB_XCNT(j)]); sum += c; cnt += (c > 0u) ? 1u : 0u; mine = (j == x) ? c : mine; }
        if (sum == G) break;
        __builtin_amdgcn_s_sleep(1);
        if ((++sp & 255u) == 0u) { if (xb_ld(&bar[XB_TMO])) break; if (sp > XB_SPIN_CAP) { atomicAdd(&bar[XB_TMO], 1u); break; } }
    }
    nloc = mine > 0u ? mine : 1u; nx = cnt > 0u ? cnt : 1u;
}

__device__ __forceinline__ void xcd_barrier(const XcdBarrier& b) {
    asm volatile("s_waitcnt vmcnt(0)" ::: "memory");
    __syncthreads();
    if (threadIdx.x == 0) {
        unsigned* bar = b.bar;
        __builtin_amdgcn_s_waitcnt(0);
        unsigned nloc = b.st[0], nx = b.st[1];
        if (nloc == 0u) { xcd_barrier_complete(bar, b.x, nloc, nx); b.st[0] = nloc; b.st[1] = nx; }
        const unsigned old = xb_add(&bar[XB_XSUB(b.x)], 1u);
        const unsigned gen = old / nloc;
        if (old + 1u == (gen + 1u) * nloc) {
            __builtin_amdgcn_fence(__ATOMIC_RELEASE, "agent");
            asm volatile("s_waitcnt vmcnt(0)" ::: "memory");
            const unsigned og = xb_add(&bar[XB_TOP], 1u);
            const unsigned tg = og / nx;
            if (og + 1u == (tg + 1u) * nx) xb_add(&bar[XB_TOPGEN], 1u);
            else XB_SPIN(xb_ld(&bar[XB_TOPGEN]) == tg, bar);
            __builtin_amdgcn_fence(__ATOMIC_ACQUIRE, "agent");
            xb_add(&bar[XB_XGEN(b.x)], 1u);
            asm volatile("s_waitcnt vmcnt(0)" ::: "memory");
        } else {
            XB_SPIN(xb_ld(&bar[XB_XGEN(b.x)]) == gen, bar);
            __builtin_amdgcn_fence(__ATOMIC_ACQUIRE, "agent");
            asm volatile("s_waitcnt vmcnt(0)" ::: "memory");
        }
    }
    __syncthreads();
}


__global__ __launch_bounds__(512, 2) void mk_fwd(Params p) {
    extern __shared__ __attribute__((aligned(16))) unsigned char shm[];
    LAS unsigned char* lds = (LAS unsigned char*)shm;
    cg::grid_group grid = cg::this_grid();
    const float* mod = (const float*)(p.ws + OFF_MOD);
    const bf16_t* A0 = (const bf16_t*)(p.ws + OFF_A0);
    bf16_t* BIG = (bf16_t*)(p.ws + OFF_BIG);
    float* XC = (float*)(p.ws + OFF_XC);

    volatile LAS unsigned* xst = (volatile LAS unsigned*)(lds + LDS_BYTES - 16);
    if (threadIdx.x == 0) { xst[0] = 0u; xst[1] = 0u; }
    __syncthreads();
    const XcdBarrier xb = xcd_barrier_post((unsigned*)(p.ws + OFF_BAR), xst);
    if (gridDim.x > 65535u * 64u) grid.sync();
    prep_phase(p, lds); xcd_barrier(xb);
    mod_phase(p, 0, 0, MT, 0); xcd_barrier(xb);
    { EpiBf16 E; E.O = BIG; E.ldc = 4096; run_gemm(lds, A0, (const bf16_t*)(p.ws + OFF_WRGIN), MT, 4096, 2048, E); } xcd_barrier(xb);
    rg_scan_phase(p, lds); xcd_barrier(xb);
    rg_combine_phase(p); xcd_barrier(xb);
    { EpiResid E; E.in_lat = p.in[I_X]; E.in_ctx = p.in[I_CTX]; E.out_lat = p.out; E.out_ctx = XC; E.gate = mod + 2 * 2048;
      if (gridDim.x >= 256) { run_gemm(lds, A0, (const bf16_t*)(p.ws + OFF_WRGOUT), ML, 2048, 2048, E); splitk_ctx_gemm(lds, p, A0, (const bf16_t*)(p.ws + OFF_WRGOUT), 2048); }
      else run_gemm(lds, A0, (const bf16_t*)(p.ws + OFF_WRGOUT), MT, 2048, 2048, E); }
    xcd_barrier(xb);
    { const float* part = gridDim.x >= 256 ? (const float*)(p.ws + OFF_PART) : nullptr; mod_phase(p, 0, 1, MT, 1, part, p.in[I_CTX], mod + (size_t)8 * 12288 + 2 * 2048); } xcd_barrier(xb);
    { EpiSwiglu E; E.O = BIG; E.ldc = FF; run_gemm(lds, A0, (const bf16_t*)(p.ws + OFF_WFFNIN0), MT, 2 * FF, 2048, E); } xcd_barrier(xb);
    { EpiResid E; E.in_lat = p.out; E.in_ctx = XC; E.out_lat = p.out; E.out_ctx = XC; E.gate = mod + 5 * 2048;
      if (gridDim.x >= 256) { run_gemm(lds, BIG, (const bf16_t*)(p.ws + OFF_WFFNOUT0), ML, 2048, FF, E); splitk_ctx_gemm(lds, p, BIG, (const bf16_t*)(p.ws + OFF_WFFNOUT0), FF); }
      else run_gemm(lds, BIG, (const bf16_t*)(p.ws + OFF_WFFNOUT0), MT, 2048, FF, E); }
    xcd_barrier(xb);
    { const float* part = gridDim.x >= 256 ? (const float*)(p.ws + OFF_PART) : nullptr; mod_phase(p, 1, 0, MT, 1, part, XC, mod + (size_t)8 * 12288 + 5 * 2048); } xcd_barrier(xb);
    { EpiBf16 E; E.O = BIG; E.ldc = 10240; pg8::Gemm g; g.A = A0; g.Bt = (const bf16_t*)(p.ws + OFF_WHGIN); g.M = MT; g.N = 10240; g.K = 2048; g.ld = 2048;
      SchedHgIn S; S.init((int)gridDim.x, (int)blockIdx.x); pg8::gemm_phase<EpiBf16, SchedHgIn, GEMM_ALIGN, GEMM_SP2>(lds, g, S, E); } xcd_barrier(xb);
    hg_scan_mfma(p, lds); xcd_barrier(xb);
    hg_combine_phase(p); xcd_barrier(xb);
    { EpiResid E; E.in_lat = p.out; E.in_ctx = XC; E.out_lat = p.out; E.out_ctx = XC; E.gate = mod + (size_t)9 * 12288 + 2 * 2048;
      run_gemm(lds, A0, (const bf16_t*)(p.ws + OFF_WHGOUT), ML, 2048, 2048, E); } xcd_barrier(xb);
    mod_phase(p, 1, 1, ML, 1); xcd_barrier(xb);
    { EpiSwiglu E; E.O = BIG; E.ldc = FF; run_gemm(lds, A0, (const bf16_t*)(p.ws + OFF_WFFNIN1), ML, 2 * FF, 2048, E); } xcd_barrier(xb);
    { EpiResid E; E.in_lat = p.out; E.in_ctx = XC; E.out_lat = p.out; E.out_ctx = XC; E.gate = mod + (size_t)9 * 12288 + 5 * 2048;
      run_gemm(lds, BIG, (const bf16_t*)(p.ws + OFF_WFFNOUT1), ML, 2048, FF, E); } xcd_barrier(xb);
    final_phase(p);
}

extern "C" void kernel_launch(void* const* d_in, const int* in_sizes, int n_in, void* d_out, int out_size, void* d_ws, size_t ws_size, hipStream_t stream) {
    static int grid = 0;
    if (grid == 0) {
        if (n_in != 24 || ws_size < WS_END) { fprintf(stderr, "kernel_launch: n_in %d ws %zu (need %zu)\n", n_in, ws_size, (size_t)WS_END); grid = -1; return; }
        int dev = 0, cus = 0, per_cu = 0;
        (void)hipGetDevice(&dev);
        (void)hipDeviceGetAttribute(&cus, hipDeviceAttributeMultiprocessorCount, dev);
        if (hipFuncSetAttribute((const void*)mk_fwd, hipFuncAttributeMaxDynamicSharedMemorySize, LDS_BYTES) != hipSuccess) fprintf(stderr, "kernel_launch: hipFuncSetAttribute failed\n");
        if (hipOccupancyMaxActiveBlocksPerMultiprocessor(&per_cu, (const void*)mk_fwd, 512, LDS_BYTES) != hipSuccess || per_cu < 1) { fprintf(stderr, "kernel_launch: occupancy query says %d\n", per_cu); per_cu = 1; }
        (void)hipGetLastError();
        grid = cus * per_cu;
    }
    if (grid < 0) return;
    Params p{};
    for (int i = 0; i < 24; ++i) p.in[i] = (const float*)d_in[i];
    p.out = (float*)d_out; p.ws = (unsigned char*)d_ws;
    (void)hipMemsetAsync((unsigned char*)d_ws + OFF_BAR, 0, XCD_BAR_WORDS * sizeof(unsigned), stream);
    void* args[] = {&p};
    const hipError_t e = hipLaunchCooperativeKernel((void*)mk_fwd, dim3(grid), dim3(512), args, LDS_BYTES, stream);
    if (e != hipSuccess) fprintf(stderr, "kernel_launch: cooperative launch failed: %s (grid %d)\n", hipGetErrorString(e), grid);
}
```

```cpp
#include <hip/hip_runtime.h>
#include <hip/hip_cooperative_groups.h>
#include <cstdio>
namespace cg = cooperative_groups;
namespace pg8 {
#define PG8_LAS __attribute__((address_space(3)))
typedef unsigned short bf16_t;
typedef short bf16x8 __attribute__((ext_vector_type(8)));
typedef float f32x4 __attribute__((ext_vector_type(4)));
typedef unsigned u32x4 __attribute__((ext_vector_type(4)));
constexpr int BM = 256, BK = 64, HALF = 128, HTB = HALF * BK * 2  , STAGE_BYTES = 8 * HTB, NXCD = 8, WGM = 4;

__host__ __device__ __forceinline__ int lds_byte(int r, int c) { const int st = (r >> 4) * 2 + (c >> 5), rr = r & 15, cc = c & 31, ob = rr * 64 + cc * 2; return st * 1024 + (ob ^ (((ob >> 9) & 1) << 5)); }
__host__ __device__ __forceinline__ void stage_rc(int b, int& R, int& C) { const int st = b / 1024, sb = b % 1024, swz = sb ^ (((sb >> 9) & 1) << 5); R = (st >> 1) * 16 + swz / 64; C = (st & 1) * 32 + (swz % 64) / 2; }
__host__ __device__ __forceinline__ int perm32(int rho) { const int n = rho >> 4, i = rho & 15; return 8 * (i >> 2) + 4 * n + (i & 3); }

struct Unit { int pm, pn; };
struct Gemm { const bf16_t* A; const bf16_t* Bt; int M, N, K, ld; };

struct StaticOrder {
    int nM, nN, nwg, G, c;
    __host__ __device__ void init(int M, int N, int G_, int c_) { nM = M / BM; nN = N / BM; nwg = nM * nN; G = G_; c = c_; }
    __host__ __device__ bool next(int i, Unit& u) const {
        const long L = (long)i * G + c; if (L >= nwg) return false;
        int wgid = (int)L; { const int q = nwg / NXCD, r = nwg % NXCD, xcd = wgid % NXCD, off = wgid / NXCD; wgid = (xcd < r ? xcd * (q + 1) : r * (q + 1) + (xcd - r) * q) + off; }
        const int nig = WGM * nN, gid = wgid / nig, fm = gid * WGM, gsz = (nM - fm) < WGM ? (nM - fm) : WGM;
        u.pm = fm + ((wgid % nig) % gsz); u.pn = (wgid % nig) / gsz; return true;
    }
    __device__ __forceinline__ void a_ready(const Unit&) const {}
    __device__ __forceinline__ void done(const Unit&) const {}
};
typedef __bf16 bf16v2_t __attribute__((ext_vector_type(2)));
typedef float f32x2v_t __attribute__((ext_vector_type(2)));
__device__ __forceinline__ unsigned cvt_pk_bf16(float lo, float hi) { const f32x2v_t v = {lo, hi}; const bf16v2_t r = __builtin_convertvector(v, bf16v2_t); return __builtin_bit_cast(unsigned, r); }
template <class Epi, class Sched, bool ALIGN_EPI = false, bool SP2 = false>
__device__ __forceinline__ void gemm_phase(PG8_LAS unsigned char* lds, const Gemm g, const Sched& S, const Epi& E) {
    int tid_ = threadIdx.x; asm volatile("" : "+v"(tid_)); const int tid = tid_, wid = __builtin_amdgcn_readfirstlane(tid >> 6), lane = tid & 63, wr = wid >> 2, wc = wid & 3, fr = lane & 15, fq = lane >> 4;
    const int K = g.ld, nt = g.K / BK;
    unsigned voffA[2], voffB[2];
#pragma unroll
    for (int i = 0; i < 2; ++i) { int R, C; stage_rc(tid * 16 + i * 8192, R, C); const int Rb = Epi::PERM ? ((R & ~31) + perm32(R & 31)) : R;
        voffA[i] = (unsigned)(R * K + C) * 2u; voffB[i] = (unsigned)(Rb * K + C) * 2u; }
    const size_t kstep = (size_t)(BK * 2);
    const size_t hstep = (size_t)HALF * K * 2;
    const size_t tstep = 2 * hstep;
    const unsigned ldsw = (unsigned)wid * 1024u;
    const int aoff = lds_byte(wr * 64 + fr, fq * 8), boff = lds_byte(wc * 32 + fr, fq * 8);
#define PG8_SA(b, h) (((b) * 2 + (h)) * HTB)
#define PG8_SB(b, h) ((4 + (b) * 2 + (h)) * HTB)
#define PG8_STAGE(bufoff, gbase, voff) do { _Pragma("unroll") for (int _i = 0; _i < 2; ++_i) \
        __builtin_amdgcn_global_load_lds((const unsigned*)((const char*)(gbase) + (voff)[_i]), (PG8_LAS unsigned*)(lds + (bufoff) + ldsw + _i * 8192), 16, 0, 0); } while (0)
#define PG8_LDA(dst, b, h) do { _Pragma("unroll") for (int m = 0; m < 4; ++m) _Pragma("unroll") for (int k = 0; k < 2; ++k) dst[m][k] = *(const PG8_LAS bf16x8*)(lds + PG8_SA(b, h) + aoff + m * 2048 + k * 1024); } while (0)
#define PG8_LDB(dst, b, h) do { _Pragma("unroll") for (int n = 0; n < 2; ++n) _Pragma("unroll") for (int k = 0; k < 2; ++k) dst[n][k] = *(const PG8_LAS bf16x8*)(lds + PG8_SB(b, h) + boff + n * 2048 + k * 1024); } while (0)
#define PG8_MMA(ai, bj, At, Bt) do { __builtin_amdgcn_s_setprio(1); _Pragma("unroll") for (int m = 0; m < 4; ++m) _Pragma("unroll") for (int n = 0; n < 2; ++n) _Pragma("unroll") for (int k = 0; k < 2; ++k) \
        acc[ai][bj][m][n] = __builtin_amdgcn_mfma_f32_16x16x32_bf16(Bt[n][k], At[m][k], acc[ai][bj][m][n], 0, 0, 0); __builtin_amdgcn_s_setprio(0); } while (0)
#define PG8_WAIT_V(n) asm volatile("s_waitcnt vmcnt(" #n ")" ::: "memory")
#define PG8_WAIT_L(n) asm volatile("s_waitcnt lgkmcnt(" #n ")" ::: "memory")
#define PG8_BAR __builtin_amdgcn_s_barrier()
#define PG8_SCHED __builtin_amdgcn_sched_barrier(0)
    Unit cur, nxt; int ui = 0;
    if (!S.next(0, cur)) return;
    f32x4 acc[2][2][4][2];
#pragma unroll
    for (int a = 0; a < 2; ++a)
#pragma unroll
        for (int b = 0; b < 2; ++b)
#pragma unroll
            for (int m = 0; m < 4; ++m)
#pragma unroll
                for (int n = 0; n < 2; ++n) acc[a][b][m][n] = (f32x4){0.f, 0.f, 0.f, 0.f};
    bf16x8 At[4][2], B0[2][2], B1[2][2];
    const char* cA = (const char*)g.A + (size_t)cur.pm * tstep; const char* cB = (const char*)g.Bt + (size_t)cur.pn * tstep;
    S.a_ready(cur);
    if constexpr (SP2) {
        PG8_STAGE(PG8_SB(0, 0), cB, voffB); PG8_STAGE(PG8_SB(0, 1), cB + hstep, voffB); PG8_STAGE(PG8_SA(0, 0), cA, voffA); PG8_STAGE(PG8_SA(0, 1), cA + hstep, voffA);
        if (wr == 1) PG8_BAR;
        PG8_WAIT_V(2); PG8_BAR;
        PG8_STAGE(PG8_SB(1, 0), cB + kstep, voffB); PG8_STAGE(PG8_SA(1, 0), cA + kstep, voffA); PG8_STAGE(PG8_SB(1, 1), cB + hstep + kstep, voffB);
        PG8_WAIT_V(6); PG8_BAR;
    } else {
        PG8_STAGE(PG8_SB(0, 0), cB, voffB); PG8_STAGE(PG8_SA(0, 0), cA, voffA); PG8_STAGE(PG8_SB(0, 1), cB + hstep, voffB); PG8_STAGE(PG8_SA(0, 1), cA + hstep, voffA);
        if (wr == 1) PG8_BAR;
        PG8_WAIT_V(4); PG8_BAR;
        PG8_STAGE(PG8_SB(1, 0), cB + kstep, voffB); PG8_STAGE(PG8_SA(1, 0), cA + kstep, voffA); PG8_STAGE(PG8_SB(1, 1), cB + hstep + kstep, voffB);
        PG8_WAIT_V(6); PG8_BAR;
    }
    for (;;) {
        const bool has_next = S.next(ui + 1, nxt);
        const char* nA = has_next ? (const char*)g.A + (size_t)nxt.pm * tstep : cA; const char* nB = has_next ? (const char*)g.Bt + (size_t)nxt.pn * tstep : cB;
        for (int t = 0; t < nt; t += 2) {
            const bool last = (t == nt - 2);
            const char* a1 = cA + (size_t)(t + 1) * kstep;
            const char* a2 = last ? nA : cA + (size_t)(t + 2) * kstep; const char* b2 = last ? nB : cB + (size_t)(t + 2) * kstep;
            const char* a3 = a2 + kstep; const char* b3 = b2 + kstep;
            if (last && has_next) S.a_ready(nxt);
            if constexpr (SP2) {
            PG8_LDB(B0, 0, 0); PG8_LDB(B1, 0, 1); PG8_SCHED; PG8_LDA(At, 0, 0); PG8_STAGE(PG8_SA(1, 1), a1 + hstep, voffA);
            PG8_WAIT_V(8); PG8_WAIT_L(0); PG8_BAR; PG8_MMA(0, 0, At, B0); PG8_MMA(0, 1, At, B1); PG8_BAR; PG8_SCHED;
            PG8_LDA(At, 0, 1); PG8_STAGE(PG8_SB(0, 0), b2, voffB); PG8_STAGE(PG8_SB(0, 1), b2 + hstep, voffB); PG8_STAGE(PG8_SA(0, 0), a2, voffA);
            PG8_WAIT_V(8); PG8_WAIT_L(0); PG8_BAR; PG8_MMA(1, 0, At, B0); PG8_MMA(1, 1, At, B1); PG8_BAR; PG8_SCHED;
            PG8_LDB(B0, 1, 0); PG8_LDB(B1, 1, 1); PG8_SCHED; PG8_LDA(At, 1, 0); PG8_STAGE(PG8_SA(0, 1), a2 + hstep, voffA);
            PG8_WAIT_V(8); PG8_WAIT_L(0); PG8_BAR; PG8_MMA(0, 0, At, B0); PG8_MMA(0, 1, At, B1); PG8_BAR; PG8_SCHED;
            PG8_LDA(At, 1, 1); PG8_STAGE(PG8_SB(1, 0), b3, voffB); PG8_STAGE(PG8_SB(1, 1), b3 + hstep, voffB); PG8_STAGE(PG8_SA(1, 0), a3, voffA);
            PG8_WAIT_V(8); PG8_WAIT_L(0); PG8_BAR; PG8_MMA(1, 0, At, B0); PG8_MMA(1, 1, At, B1); PG8_BAR; PG8_SCHED;
            } else {
            PG8_LDB(B0, 0, 0); PG8_SCHED; PG8_LDA(At, 0, 0); PG8_STAGE(PG8_SA(1, 1), a1 + hstep, voffA);
            PG8_WAIT_L(8); PG8_BAR; PG8_WAIT_L(0); PG8_MMA(0, 0, At, B0); PG8_BAR; PG8_SCHED;
            PG8_LDB(B1, 0, 1); PG8_STAGE(PG8_SB(0, 0), b2, voffB);
            PG8_BAR; PG8_WAIT_L(0); PG8_MMA(0, 1, At, B1); PG8_BAR;
            PG8_LDA(At, 0, 1); PG8_STAGE(PG8_SA(0, 0), a2, voffA);
            PG8_BAR; PG8_WAIT_L(0); PG8_MMA(1, 0, At, B0); PG8_BAR; PG8_SCHED;
            PG8_STAGE(PG8_SB(0, 1), b2 + hstep, voffB);
            PG8_WAIT_V(6); PG8_BAR; PG8_MMA(1, 1, At, B1); PG8_BAR;
            PG8_LDB(B0, 1, 0); PG8_SCHED; PG8_LDA(At, 1, 0); PG8_STAGE(PG8_SA(0, 1), a2 + hstep, voffA);
            PG8_WAIT_L(8); PG8_BAR; PG8_WAIT_L(0); PG8_MMA(0, 0, At, B0); PG8_BAR; PG8_SCHED;
            PG8_LDB(B1, 1, 1); PG8_STAGE(PG8_SB(1, 0), b3, voffB);
            PG8_BAR; PG8_WAIT_L(0); PG8_MMA(0, 1, At, B1); PG8_BAR;
            PG8_LDA(At, 1, 1); PG8_STAGE(PG8_SA(1, 0), a3, voffA);
            PG8_BAR; PG8_WAIT_L(0); PG8_MMA(1, 0, At, B0); PG8_BAR; PG8_SCHED;
            PG8_STAGE(PG8_SB(1, 1), b3 + hstep, voffB);
            PG8_WAIT_V(6); PG8_BAR; PG8_MMA(1, 1, At, B1); PG8_BAR;
            }
        }
        if constexpr (ALIGN_EPI) { if (wr == 0) PG8_BAR; }
        if constexpr (!Epi::AFTER_DRAIN) { E(acc, cur, wr, wc, fr, fq); S.done(cur); }
        if (!has_next) break;
#pragma unroll
        for (int a = 0; a < 2; ++a)
#pragma unroll
            for (int b = 0; b < 2; ++b)
#pragma unroll
                for (int m = 0; m < 4; ++m)
#pragma unroll
                    for (int n = 0; n < 2; ++n) acc[a][b][m][n] = (f32x4){0.f, 0.f, 0.f, 0.f};
        cur = nxt; cA = nA; cB = nB; ++ui;
        if constexpr (ALIGN_EPI) { if (wr == 1) PG8_BAR; }
    }
    PG8_WAIT_V(0);
    if constexpr (!ALIGN_EPI) { if (wr == 0) PG8_BAR; }
    PG8_BAR;
    if constexpr (Epi::AFTER_DRAIN) { E.fused(acc, cur, wr, wc, fr, fq, lds, wid, lane); S.done(cur); }
#undef PG8_SA
#undef PG8_SB
#undef PG8_STAGE
#undef PG8_LDA
#undef PG8_LDB
#undef PG8_MMA
#undef PG8_WAIT_V
#undef PG8_WAIT_L
#undef PG8_BAR
#undef PG8_SCHED
}
}


using pg8::bf16_t; using pg8::bf16x8; using pg8::f32x4; using pg8::u32x4; using pg8::Unit; using pg8::cvt_pk_bf16;
#define LAS __attribute__((address_space(3)))
typedef unsigned u32x2 __attribute__((ext_vector_type(2)));

constexpr int D = 2048, NB = 8, SEQ = 2048, CTXL = 256, FF = 5632;
constexpr int ML = NB * SEQ, MC = NB * CTXL, MT = ML + MC;
constexpr size_t MiB = 1048576;
constexpr size_t OFF_WRGIN = 0, OFF_WRGOUT = 16 * MiB, OFF_WFFNIN0 = 24 * MiB, OFF_WFFNIN1 = 68 * MiB, OFF_WFFNOUT0 = 112 * MiB, OFF_WFFNOUT1 = 134 * MiB,
                 OFF_WHGIN = 156 * MiB, OFF_WHGOUT = 196 * MiB, OFF_A0 = 204 * MiB, OFF_HB = 276 * MiB, OFF_BIG = 348 * MiB, OFF_XC = 708 * MiB, OFF_MOD = 724 * MiB,
                 OFF_BAR = 724 * MiB + 917504, OFF_PART = OFF_BIG + 208 * MiB  , WS_END = 725 * MiB;
constexpr int LDS_BYTES = 144 * 1024;
constexpr bool GEMM_ALIGN = true, GEMM_SP2 = true;

struct Params { const float* in[24]; float* out; unsigned char* ws; };
enum { I_X = 0, I_C, I_CTX, I_CCTX, I_WADA, I_BADA, I_GMIX, I_GFFN, I_GFINAL, I_WFFNIN, I_WFFNOUT, I_RGWIN, I_RGCONVW, I_RGCONVB, I_RGWA, I_RGBA, I_RGWI, I_RGBI, I_RGLAM,
       I_RGWOUT, I_HGWIN, I_HGLB, I_HGNORM, I_HGWOUT };

__device__ __forceinline__ int opaque_tid() { int t = threadIdx.x; asm volatile("" : "+v"(t)); return t; }
__device__ __forceinline__ float bf2f(unsigned v) { return __uint_as_float(v << 16); }
__device__ __forceinline__ float bflo(unsigned w) { return __uint_as_float(w << 16); }
__device__ __forceinline__ float bfhi(unsigned w) { return __uint_as_float(w & 0xffff0000u); }
__device__ __forceinline__ float frcp(float x) { return __builtin_amdgcn_rcpf(x); }
__device__ __forceinline__ float fexp2(float x) { return __builtin_amdgcn_exp2f(x); }
__device__ __forceinline__ float sigm(float x) { return frcp(1.0f + fexp2(-1.4426950408889634f * x)); }
__device__ __forceinline__ float silu_f(float x) { return x * frcp(1.0f + fexp2(-1.4426950408889634f * x)); }
__device__ __forceinline__ float gelu_tanh_f(float x) { const float u = 0.7978845608028654f * (x + 0.044715f * x * x * x); return x * frcp(1.0f + fexp2(-2.8853900817779268f * u)); }
template <int CTRL> __device__ __forceinline__ float dpp_f(float oldv, float src) { return __int_as_float(__builtin_amdgcn_update_dpp(__float_as_int(oldv), __float_as_int(src), CTRL, 0xf, 0xf, false)); }
__device__ __forceinline__ bf16_t f2bf(float f) { return (bf16_t)(cvt_pk_bf16(f, 0.f) & 0xffffu); }

__device__ __forceinline__ void conv_job(const Params& p, int tile, const float*& W, bf16_t*& Wt, int& K, int& N, int& mode, int& local) {
    bf16_t* ws = (bf16_t*)p.ws;
    if (tile < 1024)       { W = p.in[I_RGWIN]; Wt = (bf16_t*)(p.ws + OFF_WRGIN); K = 2048; N = 4096; mode = 0; local = tile; }
    else if (tile < 1536)  { W = p.in[I_RGWOUT]; Wt = (bf16_t*)(p.ws + OFF_WRGOUT); K = 2048; N = 2048; mode = 0; local = tile - 1024; }
    else if (tile < 4352)  { W = p.in[I_WFFNIN]; Wt = (bf16_t*)(p.ws + OFF_WFFNIN0); K = 2048; N = 11264; mode = 1; local = tile - 1536; }
    else if (tile < 7168)  { W = p.in[I_WFFNIN] + (size_t)2048 * 11264; Wt = (bf16_t*)(p.ws + OFF_WFFNIN1); K = 2048; N = 11264; mode = 1; local = tile - 4352; }
    else if (tile < 8576)  { W = p.in[I_WFFNOUT]; Wt = (bf16_t*)(p.ws + OFF_WFFNOUT0); K = 5632; N = 2048; mode = 0; local = tile - 7168; }
    else if (tile < 9984)  { W = p.in[I_WFFNOUT] + (size_t)5632 * 2048; Wt = (bf16_t*)(p.ws + OFF_WFFNOUT1); K = 5632; N = 2048; mode = 0; local = tile - 8576; }
    else if (tile < 12544) { W = p.in[I_HGWIN]; Wt = (bf16_t*)(p.ws + OFF_WHGIN); K = 2048; N = 10240; mode = 0; local = tile - 9984; }
    else                   { W = p.in[I_HGWOUT]; Wt = (bf16_t*)(p.ws + OFF_WHGOUT); K = 2048; N = 2048; mode = 0; local = tile - 12544; }
    (void)ws;
}
constexpr int N_CONV_TILES = 13056;

__device__ __forceinline__ void convert_range(const Params& p, LAS unsigned char* lds, int first, int last, int w, int nw) {
    const int tid = opaque_tid();
    LAS float* st = (LAS float*)lds;
    const int col4 = tid & 15, krow = tid >> 4;
    const int nn = tid & 63, kg = tid >> 6;
    f32x4 rg[4];
    int tile = first + w;
    if (tile < last) {
        const float* W; bf16_t* Wt; int K, N, mode, local; conv_job(p, tile, W, Wt, K, N, mode, local);
        const int ntn = N >> 6, k0 = (local / ntn) * 128, n0 = (local % ntn) * 64;
#pragma unroll
        for (int ps = 0; ps < 4; ++ps) rg[ps] = __builtin_nontemporal_load((const f32x4*)(W + (size_t)(k0 + krow + 32 * ps) * N + n0 + col4 * 4));
    }
    for (; tile < last; tile += nw) {
        const float* W; bf16_t* Wt; int K, N, mode, local; conv_job(p, tile, W, Wt, K, N, mode, local);
        const int ntn = N >> 6, k0 = (local / ntn) * 128, n0 = (local % ntn) * 64;
#pragma unroll
        for (int ps = 0; ps < 4; ++ps) *(LAS f32x4*)(st + (krow + 32 * ps) * 68 + col4 * 4) = rg[ps];
        __syncthreads();
        const int nt2 = tile + nw;
        if (nt2 < last) {
            const float* W2; bf16_t* Wt2; int K2, N2, mode2, local2; conv_job(p, nt2, W2, Wt2, K2, N2, mode2, local2);
            const int ntn2 = N2 >> 6, k02 = (local2 / ntn2) * 128, n02 = (local2 % ntn2) * 64;
#pragma unroll
            for (int ps = 0; ps < 4; ++ps) rg[ps] = __builtin_nontemporal_load((const f32x4*)(W2 + (size_t)(k02 + krow + 32 * ps) * N2 + n02 + col4 * 4));
        }
        int c = n0 + nn, dest = c;
        if (mode == 1) { const int half = c >= FF ? 1 : 0; const int j = c - half * FF; dest = (j >> 7) * 256 + half * 128 + (j & 127); }
#pragma unroll
        for (int ps = 0; ps < 2; ++ps) {
            const int kgrp = kg + 8 * ps;
            float v[8];
#pragma unroll
            for (int j = 0; j < 8; ++j) v[j] = st[(kgrp * 8 + j) * 68 + nn];
            u32x4 wv; wv.x = cvt_pk_bf16(v[0], v[1]); wv.y = cvt_pk_bf16(v[2], v[3]); wv.z = cvt_pk_bf16(v[4], v[5]); wv.w = cvt_pk_bf16(v[6], v[7]);
            *(u32x4*)(Wt + (size_t)dest * K + k0 + kgrp * 8) = wv;
        }
        __syncthreads();
    }
}

__device__ __forceinline__ void prep_phase(const Params& p, LAS unsigned char* lds) {
    const int tid = opaque_tid();
    {
        LAS float* sl = (LAS float*)lds;
        LAS float* red = (LAS float*)(lds + 73728);
        for (int idx = tid; idx < 9 * 2048; idx += 512) { const int i = idx >> 11, k = idx & 2047; const float v = (i < 8) ? p.in[I_C][i * 2048 + k] : p.in[I_CCTX][k]; sl[idx] = silu_f(v); }
        __syncthreads();
        float* mod = (float*)(p.ws + OFF_MOD);
        for (int g = blockIdx.x; g < 256; g += gridDim.x) {
            const int gc = g * 96, l = gc / 12288, n0 = gc % 12288;
            if (tid < 384) {
                const int cg4 = tid % 24, kl = tid / 24;
                f32x4 acc[9];
#pragma unroll
                for (int i = 0; i < 9; ++i) acc[i] = (f32x4){0.f, 0.f, 0.f, 0.f};
                const float* wp = p.in[I_WADA] + ((size_t)l * 2048 + kl) * 12288 + n0 + cg4 * 4;
#pragma unroll 8
                for (int kk = 0; kk < 128; ++kk) {
                    const f32x4 w = __builtin_nontemporal_load((const f32x4*)(wp + (size_t)kk * 16 * 12288));
                    const int k = kl + 16 * kk;
#pragma unroll
                    for (int i = 0; i < 9; ++i) { const float s = sl[i * 2048 + k]; acc[i] += w * s; }
                }
#pragma unroll
                for (int i = 0; i < 9; ++i) *(LAS f32x4*)(red + (kl * 9 + i) * 96 + cg4 * 4) = acc[i];
            }
            __syncthreads();
            for (int o = tid; o < 864; o += 512) {
                const int i = o / 96, col = o % 96; float s = 0.f;
#pragma unroll
                for (int kl = 0; kl < 16; ++kl) s += red[(kl * 9 + i) * 96 + col];
                mod[(size_t)(l * 9 + i) * 12288 + n0 + col] = s + p.in[I_BADA][l * 12288 + n0 + col];
            }
            __syncthreads();
        }
    }
    convert_range(p, lds, 0, N_CONV_TILES, (int)blockIdx.x, (int)gridDim.x);
}

__device__ __forceinline__ float wave_sum(float v) {
#pragma unroll
    for (int o = 32; o >= 1; o >>= 1) v += __shfl_xor(v, o);
    return v;
}
__device__ __forceinline__ void mod_phase(const Params& p, int layer, int which, int nrows, int src_mode, const float* part = nullptr, const float* rin_ctx = nullptr, const float* gate_ctx = nullptr) {
    const int tid = opaque_tid(); const int lane = tid & 63, wave = blockIdx.x * 8 + (tid >> 6), nw = gridDim.x * 8;
    const float* g = (which ? p.in[I_GFFN] : p.in[I_GMIX]) + layer * 2048;
    const float* mod = (const float*)(p.ws + OFF_MOD);
    bf16_t* A0 = (bf16_t*)(p.ws + OFF_A0);
    const float* lat = src_mode ? p.out : p.in[I_X];
    const float* ctx = src_mode ? (const float*)(p.ws + OFF_XC) : p.in[I_CTX];
    f32x4 mg[8];
#pragma unroll
    for (int j = 0; j < 8; ++j) mg[j] = *(const f32x4*)(g + lane * 4 + 256 * j);
    f32x4 vn[8];
    int r = wave;
    bool have = (r < nrows) && !(part != nullptr && r >= ML);
    if (have) { const float* src = (r < ML) ? lat + (size_t)r * 2048 : ctx + (size_t)(r - ML) * 2048;
#pragma unroll
        for (int j = 0; j < 8; ++j) vn[j] = __builtin_nontemporal_load((const f32x4*)(src + lane * 4 + 256 * j)); }
    for (; r < nrows; r += nw) {
        const int bi = (r < ML) ? (r >> 11) : 8;
        const float* sh = mod + (size_t)(layer * 9 + bi) * 12288 + (which ? 3 : 0) * 2048;
        const float* sc = sh + 2048;
        f32x4 v[8]; float ss = 0.f;
        if (have) {
#pragma unroll
            for (int j = 0; j < 8; ++j) v[j] = vn[j];
        } else {
            const size_t ro = (size_t)(r - ML) * 2048; float* xc = (float*)(p.ws + OFF_XC) + ro;
#pragma unroll
            for (int j = 0; j < 8; ++j) { const int col = lane * 4 + 256 * j;
                const f32x4 s4 = (*(const f32x4*)(part + ro + col) + *(const f32x4*)(part + (size_t)MC * 2048 + ro + col)) + (*(const f32x4*)(part + (size_t)2 * MC * 2048 + ro + col) + *(const f32x4*)(part + (size_t)3 * MC * 2048 + ro + col));
                v[j] = *(const f32x4*)(rin_ctx + ro + col) + *(const f32x4*)(gate_ctx + col) * s4;
                *(f32x4*)(xc + col) = v[j]; }
        }
        f32x4 m1[8], m0[8];
#pragma unroll
        for (int j = 0; j < 8; ++j) { const int col = lane * 4 + 256 * j; m1[j] = *(const f32x4*)(sc + col); m0[j] = *(const f32x4*)(sh + col); }
        { const int rn = r + nw; have = (rn < nrows) && !(part != nullptr && rn >= ML);
          if (have) { const float* src = (rn < ML) ? lat + (size_t)rn * 2048 : ctx + (size_t)(rn - ML) * 2048;
#pragma unroll
              for (int j = 0; j < 8; ++j) vn[j] = __builtin_nontemporal_load((const f32x4*)(src + lane * 4 + 256 * j)); } }
#pragma unroll
        for (int j = 0; j < 8; ++j) ss += v[j][0] * v[j][0] + v[j][1] * v[j][1] + v[j][2] * v[j][2] + v[j][3] * v[j][3];
        ss = wave_sum(ss);
        const float rstd = rsqrtf(ss * (1.0f / 2048.0f) + 1e-6f);
#pragma unroll
        for (int j = 0; j < 8; ++j) {
            const int col = lane * 4 + 256 * j;
            const f32x4 y = (v[j] * rstd) * mg[j] * (m1[j] + 1.0f) + m0[j];
            u32x2 w; w.x = cvt_pk_bf16(y[0], y[1]); w.y = cvt_pk_bf16(y[2], y[3]);
            *(u32x2*)(A0 + (size_t)r * 2048 + col) = w;
        }
    }
}

__device__ __forceinline__ void final_phase(const Params& p) {
    const int tid = opaque_tid(); const int lane = tid & 63, wave = blockIdx.x * 8 + (tid >> 6), nw = gridDim.x * 8;
    const float* g = p.in[I_GFINAL];
    f32x4 gg[8];
#pragma unroll
    for (int j = 0; j < 8; ++j) gg[j] = *(const f32x4*)(g + lane * 4 + 256 * j);
    f32x4 vn[8];
    int r = wave;
    if (r < ML) {
#pragma unroll
        for (int j = 0; j < 8; ++j) vn[j] = __builtin_nontemporal_load((const f32x4*)(p.out + (size_t)r * 2048 + lane * 4 + 256 * j)); }
    for (; r < ML; r += nw) {
        float* src = p.out + (size_t)r * 2048;
        f32x4 v[8]; float ss = 0.f;
#pragma unroll
        for (int j = 0; j < 8; ++j) { v[j] = vn[j]; ss += v[j][0] * v[j][0] + v[j][1] * v[j][1] + v[j][2] * v[j][2] + v[j][3] * v[j][3]; }
        if (r + nw < ML) {
#pragma unroll
            for (int j = 0; j < 8; ++j) vn[j] = __builtin_nontemporal_load((const f32x4*)(p.out + (size_t)(r + nw) * 2048 + lane * 4 + 256 * j)); }
        ss = wave_sum(ss);
        const float rstd = rsqrtf(ss * (1.0f / 2048.0f) + 1e-6f);
#pragma unroll
        for (int j = 0; j < 8; ++j) { const int col = lane * 4 + 256 * j; *(f32x4*)(src + col) = (v[j] * rstd) * gg[j]; }
    }
}

struct EpiBf16 {
    static constexpr bool PERM = true, AFTER_DRAIN = false;
    bf16_t* O; int ldc;
    __device__ __forceinline__ void operator()(const f32x4 (&acc)[2][2][4][2], const Unit& u, int wr, int wc, int fr, int fq) const {
        const int row0 = u.pm * 256 + wr * 64 + fr, col0 = u.pn * 256 + wc * 32 + 8 * fq;
#pragma unroll
        for (int ai = 0; ai < 2; ++ai)
#pragma unroll
            for (int m = 0; m < 4; ++m) { bf16_t* rowp = O + (size_t)(row0 + ai * 128 + m * 16) * ldc + col0;
#pragma unroll
                for (int bj = 0; bj < 2; ++bj) { const f32x4 v0 = acc[ai][bj][m][0], v1 = acc[ai][bj][m][1];
                    u32x4 w; w.x = cvt_pk_bf16(v0[0], v0[1]); w.y = cvt_pk_bf16(v0[2], v0[3]); w.z = cvt_pk_bf16(v1[0], v1[1]); w.w = cvt_pk_bf16(v1[2], v1[3]);
                    *(u32x4*)(rowp + bj * 128) = w; } }
    }
};
struct EpiSwiglu {
    static constexpr bool PERM = true, AFTER_DRAIN = false;
    bf16_t* O; int ldc;
    __device__ __forceinline__ void operator()(const f32x4 (&acc)[2][2][4][2], const Unit& u, int wr, int wc, int fr, int fq) const {
        const int row0 = u.pm * 256 + wr * 64 + fr, col0 = u.pn * 128 + wc * 32 + 8 * fq;
#pragma unroll
        for (int ai = 0; ai < 2; ++ai)
#pragma unroll
            for (int m = 0; m < 4; ++m) { bf16_t* rowp = O + (size_t)(row0 + ai * 128 + m * 16) * ldc + col0;
                const f32x4 g0 = acc[ai][0][m][0], g1 = acc[ai][0][m][1], u0 = acc[ai][1][m][0], u1 = acc[ai][1][m][1];
                float y[8];
#pragma unroll
                for (int j = 0; j < 4; ++j) { y[j] = silu_f(g0[j]) * u0[j]; y[4 + j] = silu_f(g1[j]) * u1[j]; }
                u32x4 w; w.x = cvt_pk_bf16(y[0], y[1]); w.y = cvt_pk_bf16(y[2], y[3]); w.z = cvt_pk_bf16(y[4], y[5]); w.w = cvt_pk_bf16(y[6], y[7]);
                *(u32x4*)rowp = w; }
    }
};
struct EpiResid {
    static constexpr bool PERM = false, AFTER_DRAIN = false;
    const float* in_lat; const float* in_ctx; float* out_lat; float* out_ctx; const float* gate;
    __device__ __forceinline__ void operator()(const f32x4 (&acc)[2][2][4][2], const Unit& u, int wr, int wc, int fr, int fq) const {
        const int row0 = u.pm * 256 + wr * 64 + fr, col0 = u.pn * 256 + wc * 32 + 4 * fq;
        const bool isl = u.pm < 64; const int bi = isl ? (u.pm >> 3) : 8;
        const float* gp = gate + (size_t)bi * 12288 + col0;
        f32x4 gv[2][2];
#pragma unroll
        for (int bj = 0; bj < 2; ++bj)
#pragma unroll
            for (int n = 0; n < 2; ++n) gv[bj][n] = *(const f32x4*)(gp + bj * 128 + n * 16);
        const float* ibase = (isl ? in_lat + (size_t)row0 * 2048 : in_ctx + (size_t)(row0 - ML) * 2048) + col0;
        float* obase = (isl ? out_lat + (size_t)row0 * 2048 : out_ctx + (size_t)(row0 - ML) * 2048) + col0;
#pragma unroll
        for (int ai = 0; ai < 2; ++ai) {
            f32x4 rv[4][2][2];
#pragma unroll
            for (int m = 0; m < 4; ++m)
#pragma unroll
                for (int bj = 0; bj < 2; ++bj)
#pragma unroll
                    for (int n = 0; n < 2; ++n) rv[m][bj][n] = *(const f32x4*)(ibase + (size_t)(ai * 128 + m * 16) * 2048 + bj * 128 + n * 16);
#pragma unroll
            for (int m = 0; m < 4; ++m)
#pragma unroll
                for (int bj = 0; bj < 2; ++bj)
#pragma unroll
                    for (int n = 0; n < 2; ++n) *(f32x4*)(obase + (size_t)(ai * 128 + m * 16) * 2048 + bj * 128 + n * 16) = rv[m][bj][n] + gv[bj][n] * acc[ai][bj][m][n];
        }
    }
};

struct SchedHgIn {
    pg8::StaticOrder lat; int G, c;
    __device__ void init(int G_, int c_) { lat.init(ML, 10240, G_, c_); G = G_; c = c_; }
    __device__ bool next(int i, Unit& u) const {
        const long L = (long)i * G + c;
        if (L < lat.nwg) return lat.next(i, u);
        const int r = (int)(L - lat.nwg); if (r >= 8 * 24) return false;
        u.pm = 64 + (r & 7); u.pn = 8 + (r >> 3); return true;
    }
    __device__ __forceinline__ void a_ready(const Unit&) const {}
    __device__ __forceinline__ void done(const Unit&) const {}
};
template <class Epi> __device__ __forceinline__ void run_gemm(LAS unsigned char* lds, const bf16_t* A, const bf16_t* Bt, int M, int N, int K, const Epi& E) {
    pg8::Gemm g; g.A = A; g.Bt = Bt; g.M = M; g.N = N; g.K = K; g.ld = K;
    pg8::StaticOrder S; S.init(M, N, (int)gridDim.x, (int)blockIdx.x);
    pg8::gemm_phase<Epi, pg8::StaticOrder, GEMM_ALIGN, GEMM_SP2>(lds, g, S, E);
}

struct SchedOne { int pm, pn; bool has;
    __device__ bool next(int i, Unit& u) const { if (i != 0 || !has) return false; u.pm = pm; u.pn = pn; return true; }
    __device__ __forceinline__ void a_ready(const Unit&) const {}
    __device__ __forceinline__ void done(const Unit&) const {} };
struct EpiPartial { static constexpr bool PERM = false, AFTER_DRAIN = false; float* P;
    __device__ __forceinline__ void operator()(const f32x4 (&acc)[2][2][4][2], const Unit& u, int wr, int wc, int fr, int fq) const {
        const int row0 = u.pm * 256 + wr * 64 + fr, col0 = u.pn * 256 + wc * 32 + 4 * fq;
#pragma unroll
        for (int ai = 0; ai < 2; ++ai)
#pragma unroll
            for (int m = 0; m < 4; ++m) { float* rowp = P + (size_t)(row0 + ai * 128 + m * 16) * 2048 + col0;
#pragma unroll
                for (int bj = 0; bj < 2; ++bj)
#pragma unroll
                    for (int n = 0; n < 2; ++n) *(f32x4*)(rowp + bj * 128 + n * 16) = acc[ai][bj][m][n]; } } };
__device__ __forceinline__ void splitk_ctx_gemm(LAS unsigned char* lds, const Params& p, const bf16_t* A, const bf16_t* Bt, int K) {
    const int c = (int)blockIdx.x, j = c >> 2, s = c & 3, Kq = K >> 2;
    pg8::Gemm g; g.A = A + (size_t)ML * K + (size_t)s * Kq; g.Bt = Bt + (size_t)s * Kq; g.M = MC; g.N = 2048; g.K = Kq; g.ld = K;
    SchedOne S; S.pm = j & 7; S.pn = j >> 3; S.has = c < 256;
    EpiPartial E; E.P = (float*)(p.ws + OFF_PART) + (size_t)s * MC * 2048;
    pg8::gemm_phase<EpiPartial, SchedOne, GEMM_ALIGN, GEMM_SP2>(lds, g, S, E);
}
__device__ __forceinline__ int rg_tok_row(int b, int dir, int s, int& tk, int& len, int& base) {
    if (s < CTXL) { tk = dir ? (CTXL - 1 - s) : s; len = CTXL; base = ML + b * CTXL; }
    else { const int s2 = s - CTXL; tk = dir ? (SEQ - 1 - s2) : s2; len = SEQ; base = b * SEQ; }
    return base + tk;
}
#define LDS_BARRIER() do { asm volatile("s_waitcnt lgkmcnt(0)" ::: "memory"); __builtin_amdgcn_s_barrier(); asm volatile("" ::: "memory"); } while (0)
__device__ __forceinline__ void rg_scan_phase(const Params& p, LAS unsigned char* lds) {
    const int tid = opaque_tid(), wid = tid >> 6, lane = tid & 63, fr = lane & 15, fq = lane >> 4;
    LAS bf16_t* sW = (LAS bf16_t*)lds;
    const bf16_t* XG = (const bf16_t*)(p.ws + OFF_BIG);
    for (int u = blockIdx.x; u < 256; u += gridDim.x) {
        const int b = u >> 5, h = (u >> 1) & 15, dir = u & 1;
        bf16_t* HO = (bf16_t*)(p.ws + (dir ? OFF_HB : OFF_A0));
        {
            const float* wa = p.in[I_RGWA] + (size_t)(dir * 16 + h) * 16384; const float* wi = p.in[I_RGWI] + (size_t)(dir * 16 + h) * 16384;
            for (int it = 0; it < 16; ++it) {
                const int idx = tid + 512 * it, mat = idx >> 12, rem = idx & 4095, e4 = rem >> 7, d = rem & 127;
                const f32x4 v = *(const f32x4*)((mat ? wi : wa) + d * 128 + e4 * 4);
#pragma unroll
                for (int j = 0; j < 4; ++j) sW[(mat * 128 + e4 * 4 + j) * 136 + d] = f2bf(v[j]);
            }
        }
        const int cch = 16 * wid + fr;
        const float ba = p.in[I_RGBA][(dir * 16 + h) * 128 + cch], bi_ = p.in[I_RGBI][(dir * 16 + h) * 128 + cch];
        const float nsp = -8.0f * 1.4426950408889634f * log1pf(expf(-p.in[I_RGLAM][dir * 2048 + h * 128 + cch]));
        float hc = 0.f;
        const int c8 = tid & 15;
        LAS float* sCW = (LAS float*)(lds + 69632 + 2 * 17408);
        for (int idx = tid; idx < 640; idx += 512) sCW[idx] = (idx < 512) ? p.in[I_RGCONVW][(idx >> 7) * 2048 + h * 128 + (idx & 127)] : p.in[I_RGCONVB][h * 128 + (idx - 512)];
        u32x4 xr[2][4];
#define RG_LOAD_TAPS(tile_) do { _Pragma("unroll") for (int ps = 0; ps < 2; ++ps) { const int i_ = (tid >> 4) + 32 * ps; int tk_, len_, base_; rg_tok_row(b, dir, (tile_) * 64 + i_, tk_, len_, base_); \
            _Pragma("unroll") for (int k = 0; k < 4; ++k) { const int tt_ = tk_ + k - 2; const bool ok_ = (tt_ >= 0) && (tt_ < len_); \
                xr[ps][k] = ok_ ? *(const u32x4*)(XG + (size_t)(base_ + (ok_ ? tt_ : tk_)) * 4096 + h * 128 + c8 * 8) : (u32x4){0u, 0u, 0u, 0u}; } } } while (0)
        RG_LOAD_TAPS(0);
        __syncthreads();
        for (int tile = 0; tile < 36; ++tile) {
            LAS bf16_t* sA = (LAS bf16_t*)(lds + 69632 + (tile & 1) * 17408);
#pragma unroll
            for (int ps = 0; ps < 2; ++ps) {
                const int i = (tid >> 4) + 32 * ps;
                float xc[8];
                { const f32x4 c0 = *(const LAS f32x4*)(sCW + 512 + c8 * 8), c1 = *(const LAS f32x4*)(sCW + 512 + c8 * 8 + 4);
                  xc[0] = c0[0]; xc[1] = c0[1]; xc[2] = c0[2]; xc[3] = c0[3]; xc[4] = c1[0]; xc[5] = c1[1]; xc[6] = c1[2]; xc[7] = c1[3]; }
#pragma unroll
                for (int k = 0; k < 4; ++k) { const u32x4 raw = xr[ps][k];
                    const f32x4 w0 = *(const LAS f32x4*)(sCW + k * 128 + c8 * 8), w1 = *(const LAS f32x4*)(sCW + k * 128 + c8 * 8 + 4);
                    xc[0] += w0[0] * bflo(raw.x); xc[1] += w0[1] * bfhi(raw.x); xc[2] += w0[2] * bflo(raw.y); xc[3] += w0[3] * bfhi(raw.y);
                    xc[4] += w1[0] * bflo(raw.z); xc[5] += w1[1] * bfhi(raw.z); xc[6] += w1[2] * bflo(raw.w); xc[7] += w1[3] * bfhi(raw.w); }
                u32x4 w; w.x = cvt_pk_bf16(xc[0], xc[1]); w.y = cvt_pk_bf16(xc[2], xc[3]); w.z = cvt_pk_bf16(xc[4], xc[5]); w.w = cvt_pk_bf16(xc[6], xc[7]);
                *(LAS u32x4*)(sA + i * 136 + c8 * 8) = w;
            }
            if (tile + 1 < 36) RG_LOAD_TAPS(tile + 1);
            LDS_BARRIER();
            f32x4 aR[4], aI[4];
#pragma unroll
            for (int tt = 0; tt < 4; ++tt) { aR[tt] = (f32x4){0.f, 0.f, 0.f, 0.f}; aI[tt] = (f32x4){0.f, 0.f, 0.f, 0.f}; }
#pragma unroll
            for (int kk = 0; kk < 4; ++kk) {
                const bf16x8 wa_f = *(const LAS bf16x8*)(sW + (16 * wid + fr) * 136 + kk * 32 + fq * 8);
                const bf16x8 wi_f = *(const LAS bf16x8*)(sW + (128 + 16 * wid + fr) * 136 + kk * 32 + fq * 8);
#pragma unroll
                for (int tt = 0; tt < 4; ++tt) { const bf16x8 xf = *(const LAS bf16x8*)(sA + (tt * 16 + fr) * 136 + kk * 32 + fq * 8);
                    aR[tt] = __builtin_amdgcn_mfma_f32_16x16x32_bf16(xf, wa_f, aR[tt], 0, 0, 0);
                    aI[tt] = __builtin_amdgcn_mfma_f32_16x16x32_bf16(xf, wi_f, aI[tt], 0, 0, 0); }
            }
            int tk0, len0, base0; const int rb0 = rg_tok_row(b, dir, tile * 64, tk0, len0, base0);
#pragma unroll
            for (int tt = 0; tt < 4; ++tt) {
                float Ap[4], Bp[4];
#pragma unroll
                for (int i = 0; i < 4; ++i) {
                    const int it = tt * 16 + 4 * fq + i;
                    const float xv = bf2f(sA[it * 136 + cch]);
                    const float r = sigm(aR[tt][i] + ba), ig = sigm(aI[tt][i] + bi_);
                    const float a = fexp2(nsp * r), bb = __builtin_amdgcn_sqrtf(fmaxf(1.0f - a * a, 0.f)) * ig * xv;
                    if (i == 0) { Ap[0] = a; Bp[0] = bb; } else { Ap[i] = Ap[i - 1] * a; Bp[i] = fmaf(a, Bp[i - 1], bb); }
                }
                float Ag = Ap[3], Bg = Bp[3];
                { const float ap = __shfl_up(Ag, 16), bp = __shfl_up(Bg, 16); if (fq >= 1) { Bg = fmaf(Ag, bp, Bg); Ag *= ap; } }
                { const float ap = __shfl_up(Ag, 32), bp = __shfl_up(Bg, 32); if (fq >= 2) { Bg = fmaf(Ag, bp, Bg); Ag *= ap; } }
                float Ae = __shfl_up(Ag, 16), Be = __shfl_up(Bg, 16); if (fq == 0) { Ae = 1.0f; Be = 0.f; }
                const float At = __shfl(Ag, fr + 48), Bt = __shfl(Bg, fr + 48);
                const float hin = fmaf(Ae, hc, Be);
                hc = fmaf(At, hc, Bt);
#pragma unroll
                for (int i = 0; i < 4; ++i) {
                    const int it = tt * 16 + 4 * fq + i; const int row = rb0 + (dir ? -it : it);
                    HO[(size_t)row * 2048 + h * 128 + cch] = f2bf(fmaf(Ap[i], hin, Bp[i]));
                }
            }
        }
        __syncthreads();
    }
}
__device__ __forceinline__ void rg_combine_phase(const Params& p) {
    bf16_t* HF = (bf16_t*)(p.ws + OFF_A0); const bf16_t* HB = (const bf16_t*)(p.ws + OFF_HB); const bf16_t* XG = (const bf16_t*)(p.ws + OFF_BIG);
    const size_t n8 = (size_t)MT * 256, gsz = (size_t)gridDim.x * 512;
    const int tid = opaque_tid();
    u32x4 an[4], bn[4], gn[4];
#define RGC_LOAD(i0_) do { _Pragma("unroll") for (int k = 0; k < 4; ++k) { const size_t i = (i0_) + k * gsz; if (i < n8) { const size_t r = i >> 8; const int c = (int)(i & 255) * 8; \
        an[k] = __builtin_nontemporal_load((const u32x4*)(HF + r * 2048 + c)); bn[k] = __builtin_nontemporal_load((const u32x4*)(HB + r * 2048 + c)); gn[k] = __builtin_nontemporal_load((const u32x4*)(XG + r * 4096 + 2048 + c)); } } } while (0)
    size_t i0 = (size_t)blockIdx.x * 512 + tid;
    RGC_LOAD(i0);
    for (; i0 < n8; i0 += gsz * 4) {
        u32x4 a[4], bq[4], gq[4];
#pragma unroll
        for (int k = 0; k < 4; ++k) { a[k] = an[k]; bq[k] = bn[k]; gq[k] = gn[k]; }
        if (i0 + gsz * 4 < n8) RGC_LOAD(i0 + gsz * 4);
#pragma unroll
        for (int k = 0; k < 4; ++k) { const size_t i = i0 + k * gsz; if (i < n8) { const size_t r = i >> 8; const int c = (int)(i & 255) * 8;
            u32x4 w;
            w.x = cvt_pk_bf16((bflo(a[k].x) + bflo(bq[k].x)) * gelu_tanh_f(bflo(gq[k].x)), (bfhi(a[k].x) + bfhi(bq[k].x)) * gelu_tanh_f(bfhi(gq[k].x)));
            w.y = cvt_pk_bf16((bflo(a[k].y) + bflo(bq[k].y)) * gelu_tanh_f(bflo(gq[k].y)), (bfhi(a[k].y) + bfhi(bq[k].y)) * gelu_tanh_f(bfhi(gq[k].y)));
            w.z = cvt_pk_bf16((bflo(a[k].z) + bflo(bq[k].z)) * gelu_tanh_f(bflo(gq[k].z)), (bfhi(a[k].z) + bfhi(bq[k].z)) * gelu_tanh_f(bfhi(gq[k].z)));
            w.w = cvt_pk_bf16((bflo(a[k].w) + bflo(bq[k].w)) * gelu_tanh_f(bflo(gq[k].w)), (bfhi(a[k].w) + bfhi(bq[k].w)) * gelu_tanh_f(bfhi(gq[k].w)));
            *(u32x4*)(HF + r * 2048 + c) = w; } }
    }
#undef RGC_LOAD
}

__device__ __forceinline__ int hg_tok_row(int b, int dir, int s) {
    if (s < CTXL) return ML + b * CTXL + (dir ? (CTXL - 1 - s) : s);
    int i = s - CTXL; if (dir) i = SEQ - 1 - i;
    const int w = i >> 5, r = i & 31;
    return b * SEQ + r * 64 + w;
}
__device__ __forceinline__ bf16x8 as_bf16x8(u32x4 v) { return __builtin_bit_cast(bf16x8, v); }
__device__ __forceinline__ void hg_scan_mfma(const Params& p, LAS unsigned char* lds) {
    const int tid = opaque_tid(), wid = tid >> 6, lane = tid & 63, fr = lane & 15, fq = lane >> 4;
    const bf16_t* QF = (const bf16_t*)(p.ws + OFF_BIG);
    constexpr int BUFB = 38400;
    for (int u = blockIdx.x; u < 256; u += gridDim.x) {
        const int b = u >> 5, h = (u >> 1) & 15, dir = u & 1;
        bf16_t* OO = (bf16_t*)(p.ws + (dir ? OFF_HB : OFF_A0));
        const int dch = 16 * wid + fr;
        const float lb = sigm(p.in[I_HGLB][4096 + dir * 2048 + h * 128 + dch] - p.in[I_HGLB][dir * 2048 + h * 128 + dch]);
        f32x4 S[8];
#pragma unroll
        for (int T = 0; T < 8; ++T) S[T] = (f32x4){0.f, 0.f, 0.f, 0.f};
        unsigned rq[8], rz[8], rv[8];
        unsigned rbo[8];
#pragma unroll
        for (int t = 0; t < 8; ++t) { const int rr = 8 * fq + t, rr2 = dir ? 31 - rr : rr; rbo[t] = (unsigned)rr2 * 20480u + (unsigned)dch * 2u; }
#define HG_ROWBASE(c_) (((c_) < 8) ? (ML + b * CTXL + (dir ? (CTXL - 32 - 32 * (c_)) : 32 * (c_))) : (b * SEQ + (dir ? (63 - ((c_) - 8)) : ((c_) - 8))))
#define HG_LOAD_RAW(c_) do { const char* qb_ = (const char*)(QF + (size_t)HG_ROWBASE(c_) * 10240 + h * 128); const char* zb_ = qb_ + (1 + dir) * 4096; const char* vb_ = qb_ + 12288; \
            _Pragma("unroll") for (int t = 0; t < 8; ++t) { rq[t] = *(const bf16_t*)(qb_ + rbo[t]); rz[t] = *(const bf16_t*)(zb_ + rbo[t]); rv[t] = *(const bf16_t*)(vb_ + rbo[t]); } } while (0)
#define HG_PREP(BO) do { LAS unsigned char* buf_ = lds + (BO); LAS bf16_t* sQ = (LAS bf16_t*)buf_; LAS bf16_t* sK = (LAS bf16_t*)(buf_ + 8704); LAS bf16_t* sKh = (LAS bf16_t*)(buf_ + 17408); \
            LAS bf16_t* sVT = (LAS bf16_t*)(buf_ + 27648); LAS float* sDec = (LAS float*)(buf_ + 37888); \
            float bl[8], kk[8]; float run = 0.f; \
            _Pragma("unroll") for (int t = 0; t < 8; ++t) { const float f = lb + (1.0f - lb) * sigm(bf2f(rz[t])); kk[t] = 1.0f - f; run += __builtin_amdgcn_logf(f); bl[t] = run; } \
            const float t0 = __shfl(run, fr), t1 = __shfl(run, fr + 16), t2 = __shfl(run, fr + 32), t3 = __shfl(run, fr + 48); \
            const float off = (fq > 0 ? t0 : 0.f) + (fq > 1 ? t1 : 0.f) + (fq > 2 ? t2 : 0.f), blast = (t0 + t1) + (t2 + t3); \
            float kh[8]; const float dlast = fexp2(blast); \
            _Pragma("unroll") for (int t = 0; t < 8; ++t) { const float bt = bl[t] + off; const float eb = fexp2(bt), ieb = frcp(eb); const float qt = bf2f(rq[t]) * 0.08838834764831845f * eb, kt = kk[t] * ieb; kh[t] = kt * dlast; \
                sQ[(8 * fq + t) * 136 + dch] = f2bf(qt); sK[(8 * fq + t) * 136 + dch] = f2bf(kt); } \
            u32x4 w; w.x = cvt_pk_bf16(kh[0], kh[1]); w.y = cvt_pk_bf16(kh[2], kh[3]); w.z = cvt_pk_bf16(kh[4], kh[5]); w.w = cvt_pk_bf16(kh[6], kh[7]); \
            *(LAS u32x4*)(sKh + dch * 40 + 8 * fq) = w; \
            u32x4 vw; vw.x = rv[0] | (rv[1] << 16); vw.y = rv[2] | (rv[3] << 16); vw.z = rv[4] | (rv[5] << 16); vw.w = rv[6] | (rv[7] << 16); \
            *(LAS u32x4*)(sVT + dch * 40 + 8 * fq) = vw; \
            if (fq == 0) sDec[dch] = dlast; } while (0)
#define HG_OUT(BO, c_) do { LAS unsigned char* buf_ = lds + (BO); LAS bf16_t* sQ = (LAS bf16_t*)buf_; LAS bf16_t* sK = (LAS bf16_t*)(buf_ + 8704); LAS bf16_t* sVT = (LAS bf16_t*)(buf_ + 27648); \
            f32x4 T00 = (f32x4){0.f, 0.f, 0.f, 0.f}, T01 = T00, T11 = T00; \
            _Pragma("unroll") for (int kk = 0; kk < 4; ++kk) { \
                const bf16x8 ak0 = *(const LAS bf16x8*)(sK + fr * 136 + 32 * kk + 8 * fq), ak1 = *(const LAS bf16x8*)(sK + (16 + fr) * 136 + 32 * kk + 8 * fq); \
                const bf16x8 bq0 = *(const LAS bf16x8*)(sQ + fr * 136 + 32 * kk + 8 * fq), bq1 = *(const LAS bf16x8*)(sQ + (16 + fr) * 136 + 32 * kk + 8 * fq); \
                T00 = __builtin_amdgcn_mfma_f32_16x16x32_bf16(ak0, bq0, T00, 0, 0, 0); \
                T01 = __builtin_amdgcn_mfma_f32_16x16x32_bf16(ak0, bq1, T01, 0, 0, 0); \
                T11 = __builtin_amdgcn_mfma_f32_16x16x32_bf16(ak1, bq1, T11, 0, 0, 0); } \
            _Pragma("unroll") for (int i = 0; i < 4; ++i) if (4 * fq + i > fr) { T00[i] = 0.f; T11[i] = 0.f; } \
            u32x4 P0, P1; \
            P0.x = cvt_pk_bf16(T00[0], T00[1]); P0.y = cvt_pk_bf16(T00[2], T00[3]); P0.z = 0u; P0.w = 0u; \
            P1.x = cvt_pk_bf16(T01[0], T01[1]); P1.y = cvt_pk_bf16(T01[2], T01[3]); P1.z = cvt_pk_bf16(T11[0], T11[1]); P1.w = cvt_pk_bf16(T11[2], T11[3]); \
            f32x4 O0 = (f32x4){0.f, 0.f, 0.f, 0.f}, O1 = O0; \
            { const u32x2 vlo = *(const LAS u32x2*)(sVT + dch * 40 + 4 * fq), vhi = *(const LAS u32x2*)(sVT + dch * 40 + 16 + 4 * fq); \
              u32x4 av; av.x = vlo.x; av.y = vlo.y; av.z = vhi.x; av.w = vhi.y; \
              O0 = __builtin_amdgcn_mfma_f32_16x16x32_bf16(as_bf16x8(av), as_bf16x8(P0), O0, 0, 0, 0); \
              O1 = __builtin_amdgcn_mfma_f32_16x16x32_bf16(as_bf16x8(av), as_bf16x8(P1), O1, 0, 0, 0); } \
            _Pragma("unroll") for (int kk = 0; kk < 4; ++kk) { \
                u32x4 as; as.x = cvt_pk_bf16(S[2 * kk][0], S[2 * kk][1]); as.y = cvt_pk_bf16(S[2 * kk][2], S[2 * kk][3]); \
                as.z = cvt_pk_bf16(S[2 * kk + 1][0], S[2 * kk + 1][1]); as.w = cvt_pk_bf16(S[2 * kk + 1][2], S[2 * kk + 1][3]); \
                const u32x2 q0l = *(const LAS u32x2*)(sQ + fr * 136 + 32 * kk + 4 * fq), q0h = *(const LAS u32x2*)(sQ + fr * 136 + 32 * kk + 16 + 4 * fq); \
                const u32x2 q1l = *(const LAS u32x2*)(sQ + (16 + fr) * 136 + 32 * kk + 4 * fq), q1h = *(const LAS u32x2*)(sQ + (16 + fr) * 136 + 32 * kk + 16 + 4 * fq); \
                u32x4 b0; b0.x = q0l.x; b0.y = q0l.y; b0.z = q0h.x; b0.w = q0h.y; \
                u32x4 b1; b1.x = q1l.x; b1.y = q1l.y; b1.z = q1h.x; b1.w = q1h.y; \
                O0 = __builtin_amdgcn_mfma_f32_16x16x32_bf16(as_bf16x8(as), as_bf16x8(b0), O0, 0, 0, 0); \
                O1 = __builtin_amdgcn_mfma_f32_16x16x32_bf16(as_bf16x8(as), as_bf16x8(b1), O1, 0, 0, 0); } \
            { const int rb_ = HG_ROWBASE(c_); const int row0 = rb_ + (dir ? 31 - fr : fr) * 64, row1 = rb_ + (dir ? 15 - fr : 16 + fr) * 64; \
              u32x2 w0; w0.x = cvt_pk_bf16(O0[0], O0[1]); w0.y = cvt_pk_bf16(O0[2], O0[3]); \
              u32x2 w1; w1.x = cvt_pk_bf16(O1[0], O1[1]); w1.y = cvt_pk_bf16(O1[2], O1[3]); \
              *(u32x2*)(OO + (size_t)row0 * 2048 + h * 128 + 16 * wid + 4 * fq) = w0; \
              *(u32x2*)(OO + (size_t)row1 * 2048 + h * 128 + 16 * wid + 4 * fq) = w1; } } while (0)
#define HG_UPD(BO) do { LAS unsigned char* buf_ = lds + (BO); LAS bf16_t* sKh = (LAS bf16_t*)(buf_ + 17408); LAS bf16_t* sVT = (LAS bf16_t*)(buf_ + 27648); LAS float* sDec = (LAS float*)(buf_ + 37888); \
            const bf16x8 bv = *(const LAS bf16x8*)(sVT + dch * 40 + 8 * fq); \
            _Pragma("unroll") for (int T = 0; T < 8; ++T) { \
                const f32x4 dec = *(const LAS f32x4*)(sDec + 16 * T + 4 * fq); \
                const bf16x8 akh = *(const LAS bf16x8*)(sKh + (16 * T + fr) * 40 + 8 * fq); \
                S[T] = __builtin_amdgcn_mfma_f32_16x16x32_bf16(akh, bv, S[T] * dec, 0, 0, 0); } } while (0)
        HG_LOAD_RAW(0); HG_PREP(0); HG_LOAD_RAW(1);
        for (int c = 0; c < 8; c += 2) {
            LDS_BARRIER(); HG_UPD(0); HG_PREP(BUFB);
            if (c + 2 == 8) {
#pragma unroll
                for (int t = 0; t < 8; ++t) { const int rr = 8 * fq + t, rr2 = dir ? 31 - rr : rr; rbo[t] = (unsigned)rr2 * (64u * 20480u) + (unsigned)dch * 2u; }
            }
            HG_LOAD_RAW(c + 2);
            LDS_BARRIER(); HG_UPD(BUFB); HG_PREP(0); HG_LOAD_RAW(c + 3);
        }
        for (int c = 8; c < 72; c += 2) {
            LDS_BARRIER(); HG_OUT(0, c); HG_UPD(0); HG_PREP(BUFB);
            if (c + 2 < 72) HG_LOAD_RAW(c + 2);
            LDS_BARRIER(); HG_OUT(BUFB, c + 1); HG_UPD(BUFB);
            if (c + 2 < 72) { HG_PREP(0); if (c + 3 < 72) HG_LOAD_RAW(c + 3); }
        }
        __syncthreads();
    }
}
__device__ __forceinline__ void hg_combine_phase(const Params& p) {
    const int tid = opaque_tid(); const int lane = tid & 63, wave = blockIdx.x * 8 + (tid >> 6), nw = gridDim.x * 8;
    bf16_t* OF = (bf16_t*)(p.ws + OFF_A0); const bf16_t* OB = (const bf16_t*)(p.ws + OFF_HB); const bf16_t* QF = (const bf16_t*)(p.ws + OFF_BIG);
    const int e4 = (lane & 31) * 4;
    const f32x4 nw4 = *(const f32x4*)(p.in[I_HGNORM] + e4);
    u32x2 an[8], bn[8], gn[8];
#define HGC_LOAD(pr0_) do { _Pragma("unroll") for (int k = 0; k < 8; ++k) { const int pr = (pr0_) + k * nw; if (pr < ML * 8) { const int r = pr >> 3, col = ((pr & 7) * 2 + (lane >> 5)) * 128 + e4; \
        an[k] = __builtin_nontemporal_load((const u32x2*)(OF + (size_t)r * 2048 + col)); bn[k] = __builtin_nontemporal_load((const u32x2*)(OB + (size_t)r * 2048 + col)); \
        gn[k] = __builtin_nontemporal_load((const u32x2*)(QF + (size_t)r * 10240 + 4 * 2048 + col)); } } } while (0)
    int pr0 = wave;
    HGC_LOAD(pr0);
    for (; pr0 < ML * 8; pr0 += nw * 8) {
        u32x2 a[8], bq[8], gq[8];
#pragma unroll
        for (int k = 0; k < 8; ++k) { a[k] = an[k]; bq[k] = bn[k]; gq[k] = gn[k]; }
        if (pr0 + nw * 8 < ML * 8) HGC_LOAD(pr0 + nw * 8);
#pragma unroll
        for (int k = 0; k < 8; ++k) { const int pr = pr0 + k * nw; if (pr < ML * 8) { const int r = pr >> 3, col = ((pr & 7) * 2 + (lane >> 5)) * 128 + e4;
            float o[4] = {bflo(a[k].x) + bflo(bq[k].x), bfhi(a[k].x) + bfhi(bq[k].x), bflo(a[k].y) + bflo(bq[k].y), bfhi(a[k].y) + bfhi(bq[k].y)};
            float ss = o[0] * o[0] + o[1] * o[1] + o[2] * o[2] + o[3] * o[3];
#pragma unroll
            for (int off = 16; off >= 1; off >>= 1) ss += __shfl_xor(ss, off);
            const float rstd = rsqrtf(ss * (1.0f / 128.0f) + 1e-6f);
            const float g[4] = {bflo(gq[k].x), bfhi(gq[k].x), bflo(gq[k].y), bfhi(gq[k].y)};
            float y[4];
#pragma unroll
            for (int j = 0; j < 4; ++j) y[j] = o[j] * rstd * nw4[j] * silu_f(g[j]);
            u32x2 w; w.x = cvt_pk_bf16(y[0], y[1]); w.y = cvt_pk_bf16(y[2], y[3]);
            *(u32x2*)(OF + (size_t)r * 2048 + col) = w; } }
    }
#undef HGC_LOAD
}

#define XB_TMO      128
#define XB_XCNT(j)  (256  + 64 * (j))
#define XB_XSUB(j)  (1280 + 64 * (j))
#define XB_XGEN(j)  (2304 + 64 * (j))
#define XB_TOP      3328
#define XB_TOPGEN   3392
#define XCD_BAR_WORDS 3456
#define XB_SPIN_CAP (1u << 18)

__device__ __forceinline__ unsigned xb_ld(unsigned* p)              { return __hip_atomic_load(p, __ATOMIC_RELAXED, __HIP_MEMORY_SCOPE_AGENT); }
__device__ __forceinline__ unsigned xb_add(unsigned* p, unsigned v) { return __hip_atomic_fetch_add(p, v, __ATOMIC_RELAXED, __HIP_MEMORY_SCOPE_AGENT); }
__device__ __forceinline__ unsigned xb_xcc_id() { return (unsigned)__builtin_amdgcn_s_getreg((3 << 11) | 20) & 0xFu; }
#define XB_SPIN(cond, bar) do { unsigned _sp = 0; while (cond) { __builtin_amdgcn_s_sleep(1); \
    if ((++_sp & 255u) == 0u) { if (xb_ld(&(bar)[XB_TMO])) break; if (_sp > XB_SPIN_CAP) { atomicAdd(&(bar)[XB_TMO], 1u); break; } } } } while (0)

struct XcdBarrier {
    unsigned* bar; unsigned x;
    volatile LAS unsigned* st;
};

__device__ __forceinline__ XcdBarrier xcd_barrier_post(unsigned* bar, volatile LAS unsigned* st) {
    XcdBarrier b; b.bar = bar; b.x = xb_xcc_id(); b.st = st;
    if (threadIdx.x == 0) (void)xb_add(&bar[XB_XCNT(b.x)], 1u);
    return b;
}
__device__ __forceinline__ void xcd_barrier_complete(unsigned* bar, unsigned x, unsigned& nloc, unsigned& nx) {
    const unsigned G = gridDim.x * gridDim.y * gridDim.z;
    unsigned sum, cnt, mine, sp = 0u;
    for (;;) {
        sum = 0u; cnt = 0u; mine = 0u;
#pragma unroll
        for (unsigned j = 0; j < 16; ++j) { const unsigned c = xb_ld(&bar[XB_XCNT(j)]); sum += c; cnt += (c > 0u) ? 1u : 0u; mine = (j == x) ? c : mine; }
        if (sum == G) break;
        __builtin_amdgcn_s_sleep(1);
        if ((++sp & 255u) == 0u) { if (xb_ld(&bar[XB_TMO])) break; if (sp > XB_SPIN_CAP) { atomicAdd(&bar[XB_TMO], 1u); break; } }
    }
    nloc = mine > 0u ? mine : 1u; nx = cnt > 0u ? cnt : 1u;
}

__device__ __forceinline__ void xcd_barrier(const XcdBarrier& b) {
    asm volatile("s_waitcnt vmcnt(0)" ::: "memory");
    __syncthreads();
    if (threadIdx.x == 0) {
        unsigned* bar = b.bar;
        __builtin_amdgcn_s_waitcnt(0);
        unsigned nloc = b.st[0], nx = b.st[1];
        if (nloc == 0u) { xcd_barrier_complete(bar, b.x, nloc, nx); b.st[0] = nloc; b.st[1] = nx; }
        const unsigned old = xb_add(&bar[XB_XSUB(b.x)], 1u);
        const unsigned gen = old / nloc;
        if (old + 1u == (gen + 1u) * nloc) {
            __builtin_amdgcn_fence(__ATOMIC_RELEASE, "agent");
            asm volatile("s_waitcnt vmcnt(0)" ::: "memory");
            const unsigned og = xb_add(&bar[XB_TOP], 1u);
            const unsigned tg = og / nx;
            if (og + 1u == (tg + 1u) * nx) xb_add(&bar[XB_TOPGEN], 1u);
            else XB_SPIN(xb_ld(&bar[XB_TOPGEN]) == tg, bar);
            __builtin_amdgcn_fence(__ATOMIC_ACQUIRE, "agent");
            xb_add(&bar[XB_XGEN(b.x)], 1u);
            asm volatile("s_waitcnt vmcnt(0)" ::: "memory");
        } else {
            XB_SPIN(xb_ld(&bar[XB_XGEN(b.x)]) == gen, bar);
            __builtin_amdgcn_fence(__ATOMIC_ACQUIRE, "agent");
            asm volatile("s_waitcnt vmcnt(0)" ::: "memory");
        }
    }
    __syncthreads();
}


__global__ __launch_bounds__(512, 2) void mk_fwd(Params p) {
    extern __shared__ __attribute__((aligned(16))) unsigned char shm[];
    LAS unsigned char* lds = (LAS unsigned char*)shm;
    cg::grid_group grid = cg::this_grid();
    const float* mod = (const float*)(p.ws + OFF_MOD);
    const bf16_t* A0 = (const bf16_t*)(p.ws + OFF_A0);
    bf16_t* BIG = (bf16_t*)(p.ws + OFF_BIG);
    float* XC = (float*)(p.ws + OFF_XC);

    volatile LAS unsigned* xst = (volatile LAS unsigned*)(lds + LDS_BYTES - 16);
    if (threadIdx.x == 0) { xst[0] = 0u; xst[1] = 0u; }
    __syncthreads();
    const XcdBarrier xb = xcd_barrier_post((unsigned*)(p.ws + OFF_BAR), xst);
    if (gridDim.x > 65535u * 64u) grid.sync();
    prep_phase(p, lds); xcd_barrier(xb);
    mod_phase(p, 0, 0, MT, 0); xcd_barrier(xb);
    { EpiBf16 E; E.O = BIG; E.ldc = 4096; run_gemm(lds, A0, (const bf16_t*)(p.ws + OFF_WRGIN), MT, 4096, 2048, E); } xcd_barrier(xb);
    rg_scan_phase(p, lds); xcd_barrier(xb);
    rg_combine_phase(p); xcd_barrier(xb);
    { EpiResid E; E.in_lat = p.in[I_X]; E.in_ctx = p.in[I_CTX]; E.out_lat = p.out; E.out_ctx = XC; E.gate = mod + 2 * 2048;
      if (gridDim.x >= 256) { run_gemm(lds, A0, (const bf16_t*)(p.ws + OFF_WRGOUT), ML, 2048, 2048, E); splitk_ctx_gemm(lds, p, A0, (const bf16_t*)(p.ws + OFF_WRGOUT), 2048); }
      else run_gemm(lds, A0, (const bf16_t*)(p.ws + OFF_WRGOUT), MT, 2048, 2048, E); }
    xcd_barrier(xb);
    { const float* part = gridDim.x >= 256 ? (const float*)(p.ws + OFF_PART) : nullptr; mod_phase(p, 0, 1, MT, 1, part, p.in[I_CTX], mod + (size_t)8 * 12288 + 2 * 2048); } xcd_barrier(xb);
    { EpiSwiglu E; E.O = BIG; E.ldc = FF; run_gemm(lds, A0, (const bf16_t*)(p.ws + OFF_WFFNIN0), MT, 2 * FF, 2048, E); } xcd_barrier(xb);
    { EpiResid E; E.in_lat = p.out; E.in_ctx = XC; E.out_lat = p.out; E.out_ctx = XC; E.gate = mod + 5 * 2048;
      if (gridDim.x >= 256) { run_gemm(lds, BIG, (const bf16_t*)(p.ws + OFF_WFFNOUT0), ML, 2048, FF, E); splitk_ctx_gemm(lds, p, BIG, (const bf16_t*)(p.ws + OFF_WFFNOUT0), FF); }
      else run_gemm(lds, BIG, (const bf16_t*)(p.ws + OFF_WFFNOUT0), MT, 2048, FF, E); }
    xcd_barrier(xb);
    { const float* part = gridDim.x >= 256 ? (const float*)(p.ws + OFF_PART) : nullptr; mod_phase(p, 1, 0, MT, 1, part, XC, mod + (size_t)8 * 12288 + 5 * 2048); } xcd_barrier(xb);
    { EpiBf16 E; E.O = BIG; E.ldc = 10240; pg8::Gemm g; g.A = A0; g.Bt = (const bf16_t*)(p.ws + OFF_WHGIN); g.M = MT; g.N = 10240; g.K = 2048; g.ld = 2048;
      SchedHgIn S; S.init((int)gridDim.x, (int)blockIdx.x); pg8::gemm_phase<EpiBf16, SchedHgIn, GEMM_ALIGN, GEMM_SP2>(lds, g, S, E); } xcd_barrier(xb);
    hg_scan_mfma(p, lds); xcd_barrier(xb);
    hg_combine_phase(p); xcd_barrier(xb);
    { EpiResid E; E.in_lat = p.out; E.in_ctx = XC; E.out_lat = p.out; E.out_ctx = XC; E.gate = mod + (size_t)9 * 12288 + 2 * 2048;
      run_gemm(lds, A0, (const bf16_t*)(p.ws + OFF_WHGOUT), ML, 2048, 2048, E); } xcd_barrier(xb);
    mod_phase(p, 1, 1, ML, 1); xcd_barrier(xb);
    { EpiSwiglu E; E.O = BIG; E.ldc = FF; run_gemm(lds, A0, (const bf16_t*)(p.ws + OFF_WFFNIN1), ML, 2 * FF, 2048, E); } xcd_barrier(xb);
    { EpiResid E; E.in_lat = p.out; E.in_ctx = XC; E.out_lat = p.out; E.out_ctx = XC; E.gate = mod + (size_t)9 * 12288 + 5 * 2048;
      run_gemm(lds, BIG, (const bf16_t*)(p.ws + OFF_WFFNOUT1), ML, 2048, FF, E); } xcd_barrier(xb);
    final_phase(p);
}

extern "C" void kernel_launch(void* const* d_in, const int* in_sizes, int n_in, void* d_out, int out_size, void* d_ws, size_t ws_size, hipStream_t stream) {
    static int grid = 0;
    if (grid == 0) {
        if (n_in != 24 || ws_size < WS_END) { fprintf(stderr, "kernel_launch: n_in %d ws %zu (need %zu)\n", n_in, ws_size, (size_t)WS_END); grid = -1; return; }
        int dev = 0, cus = 0, per_cu = 0;
        (void)hipGetDevice(&dev);
        (void)hipDeviceGetAttribute(&cus, hipDeviceAttributeMultiprocessorCount, dev);
        if (hipFuncSetAttribute((const void*)mk_fwd, hipFuncAttributeMaxDynamicSharedMemorySize, LDS_BYTES) != hipSuccess) fprintf(stderr, "kernel_launch: hipFuncSetAttribute failed\n");
        if (hipOccupancyMaxActiveBlocksPerMultiprocessor(&per_cu, (const void*)mk_fwd, 512, LDS_BYTES) != hipSuccess || per_cu < 1) { fprintf(stderr, "kernel_launch: occupancy query says %d\n", per_cu); per_cu = 1; }
        (void)hipGetLastError();
        grid = cus * per_cu;
    }
    if (grid < 0) return;
    Params p{};
    for (int i = 0; i < 24; ++i) p.in[i] = (const float*)d_in[i];
    p.out = (float*)d_out; p.ws = (unsigned char*)d_ws;
    (void)hipMemsetAsync((unsigned char*)d_ws + OFF_BAR, 0, XCD_BAR_WORDS * sizeof(unsigned), stream);
    void* args[] = {&p};
    const hipError_t e = hipLaunchCooperativeKernel((void*)mk_fwd, dim3(grid), dim3(512), args, LDS_BYTES, stream);
    if (e != hipSuccess) fprintf(stderr, "kernel_launch: cooperative launch failed: %s (grid %d)\n", hipGetErrorString(e), grid);
}
```
